# Optimizing an MI355X kernel written in HIP

```python
import math
import jax, jax.numpy as jnp
from jax import lax
import numpy as np

D_MODEL = 1024
BATCH = 4
SEQ = 8192
DEPTH = 4

HEAD_DIM = 64
BLK = 128
A_HEADS = 8
A_PATTERNS = ((128, 1), (512, 4), (2048, 16))
A_PAD = BLK * 16
B_HEADS = 8
B_KV_HEADS = 2
B_WINDOW = 128
C_HEADS = 16
IDX_HEADS = 8
IDX_DIM = 64
TOPK_MAX = 256
REL_BUCKETS = 32
REL_MAX_DIST = 2048
REL_HEADS = 16
D_FF = 3584
N_EXPERTS = 8
TOP_K = 2
MOE_BLOCK = 512
ALPHA = (2 * DEPTH) ** 0.25
BETA = (8 * DEPTH) ** -0.25
LN_EPS = 1e-5

N_EVEN = (DEPTH + 1) // 2
N_ODD = DEPTH // 2
EVEN_SIZES = (A_HEADS * HEAD_DIM, A_HEADS * HEAD_DIM, A_HEADS * HEAD_DIM,
              B_HEADS * HEAD_DIM, B_KV_HEADS * HEAD_DIM, B_KV_HEADS * HEAD_DIM)
EVEN_IN = sum(EVEN_SIZES)
EVEN_MIX = (A_HEADS + B_HEADS) * HEAD_DIM
ODD_SIZES = (C_HEADS * HEAD_DIM, HEAD_DIM, HEAD_DIM, IDX_HEADS * IDX_DIM, IDX_DIM, IDX_HEADS)
ODD_IN = sum(ODD_SIZES)
ODD_MIX = C_HEADS * HEAD_DIM

kernel_name = "hybrid_dilated_swa_dsa_moe_trunk"


def _split(t, sizes):
    return jnp.split(t, [int(s) for s in np.cumsum(sizes)[:-1]], axis=-1)


def t5_bucket(dist):
    n = jnp.maximum(dist, 0)
    max_exact = REL_BUCKETS // 2
    nf = jnp.maximum(n, 1).astype(jnp.float32)
    large = max_exact + (jnp.log(nf / max_exact) / math.log(REL_MAX_DIST / max_exact)
                         * (REL_BUCKETS - max_exact)).astype(jnp.int32)
    large = jnp.minimum(large, REL_BUCKETS - 1)
    return jnp.where(n < max_exact, n, large)


def layer_norm(x, g, b):
    xf = x.astype(jnp.float32)
    mu = jnp.mean(xf, axis=-1, keepdims=True)
    var = jnp.mean(jnp.square(xf - mu), axis=-1, keepdims=True)
    return ((xf - mu) * lax.rsqrt(var + LN_EPS) * g + b).astype(x.dtype)


def ada_modulation(c, w, b):
    mod = jax.nn.silu(c) @ w + b
    shift, scale, gate = jnp.split(mod, 3, axis=-1)
    return shift[:, None], 1.0 + scale[:, None], 1.0 + gate[:, None]


def banded_attention(q, k, v, rel_table, dilation, max_dist, sinks=None):
    N, L, Hq, hd = q.shape
    Hk = k.shape[2]
    G = Hq // Hk
    nb = L // BLK
    qb = q.reshape(N, nb, BLK, Hk, G, hd)

    def band(t):
        t = t.reshape(N, nb, BLK, Hk, hd)
        prev = jnp.concatenate([jnp.zeros_like(t[:, :1]), t[:, :-1]], axis=1)
        return jnp.concatenate([prev, t], axis=2)

    kband, vband = band(k), band(v)
    logits = jnp.einsum('nbqhgd,nbkhd->nbhgqk', qb, kband,
                        preferred_element_type=jnp.float32) * (hd ** -0.5)
    qi = jnp.arange(BLK)[:, None]
    kj = jnp.arange(2 * BLK)[None, :]
    dist = qi + BLK - kj
    bias = rel_table[t5_bucket(dist * dilation)]
    bias = bias.reshape(BLK, 2 * BLK, Hk, G).transpose(2, 3, 0, 1).astype(jnp.float32)
    blk_id = jnp.arange(nb)[:, None, None]
    mask = (dist >= 0) & (dist <= max_dist) & ((blk_id > 0) | (kj >= BLK))
    logits = jnp.where(mask[None, :, None, None], logits + bias, -jnp.inf)
    if sinks is not None:
        s = jnp.broadcast_to(sinks.astype(jnp.float32).reshape(Hk, G, 1, 1), logits.shape[:-1] + (1,))
        lse = jax.nn.logsumexp(jnp.concatenate([logits, s], axis=-1), axis=-1)
    else:
        lse = jax.nn.logsumexp(logits, axis=-1)
    p = jnp.exp(logits - lse[..., None])
    o = jnp.einsum('nbhgqk,nbkhd->nbqhgd', p.astype(v.dtype), vband).reshape(N, L, Hq, hd)
    lse = lse.transpose(0, 1, 4, 2, 3).reshape(N, L, Hq)
    return o, lse


def dilated_attention(q, k, v, rel_table):
    B, S, H, hd = q.shape
    Sp = -(-S // A_PAD) * A_PAD
    padw = ((0, 0), (0, Sp - S), (0, 0), (0, 0))
    qp, kp, vp = jnp.pad(q, padw), jnp.pad(k, padw), jnp.pad(v, padw)
    outs, lses = [], []
    for window, d in A_PATTERNS:
        Ld = Sp // d

        def regroup(t):
            return t.reshape(B, Ld, d, H, hd).transpose(0, 2, 1, 3, 4).reshape(B * d, Ld, H, hd)

        o, lse = banded_attention(regroup(qp), regroup(kp), regroup(vp), rel_table, d, window // d)
        outs.append(o.reshape(B, d, Ld, H, hd).transpose(0, 2, 1, 3, 4).reshape(B, Sp, H, hd))
        lses.append(lse.reshape(B, d, Ld, H).transpose(0, 2, 1, 3).reshape(B, Sp, H))
    wts = jax.nn.softmax(jnp.stack(lses), axis=0)
    o = jnp.einsum('pbsh,pbshd->bshd', wts, jnp.stack(outs).astype(jnp.float32))
    return o[:, :S].astype(q.dtype)


def even_mixer(h, w_in, w_out, rel_table, sinks):
    B, S, _ = h.shape
    qa, ka, va, qb, kb, vb = _split(h @ w_in, EVEN_SIZES)
    heads = lambda t, n: t.reshape(B, S, n, HEAD_DIM)
    oa = dilated_attention(heads(qa, A_HEADS), heads(ka, A_HEADS), heads(va, A_HEADS),
                           rel_table[:, :A_HEADS])
    ob, _ = banded_attention(heads(qb, B_HEADS), heads(kb, B_KV_HEADS), heads(vb, B_KV_HEADS),
                             rel_table[:, A_HEADS:A_HEADS + B_HEADS], 1, B_WINDOW - 1, sinks)
    o = jnp.concatenate([oa.reshape(B, S, -1), ob.reshape(B, S, -1)], axis=-1)
    return o @ w_out


def dsa_mixer(h, w_in, w_out, rel_table):
    B, S, _ = h.shape
    nb = S // BLK
    k_sel = min(TOPK_MAX, S // 4)
    q, kc, vc, qi, ki, wi = _split(h @ w_in, ODD_SIZES)
    q = q.reshape(B, S, C_HEADS, HEAD_DIM)
    qi = qi.reshape(B, S, IDX_HEADS, IDX_DIM)
    wi = wi * (IDX_HEADS ** -0.5 * IDX_DIM ** -0.5)
    table = rel_table[:, :C_HEADS]
    gather = jax.vmap(lambda t, i: t[i])

    def to_blocks(t):
        return t.reshape((B, nb, BLK) + t.shape[2:]).swapaxes(0, 1)

    def block(args):
        b, qb, qib, wib = args
        tpos = b * BLK + jnp.arange(BLK)
        dots = jnp.einsum('bqhd,bsd->bqhs', qib, ki, preferred_element_type=jnp.float32)
        scores = jnp.einsum('bqhs,bqh->bqs', jax.nn.relu(dots), wib.astype(jnp.float32))
        admissible = jnp.arange(S)[None, :] <= tpos[:, None]
        scores = jnp.where(admissible[None], scores, -jnp.inf)
        _, idx = lax.top_k(scores, k_sel)
        valid = idx <= tpos[None, :, None]
        ks, vs = gather(kc, idx), gather(vc, idx)
        logits = jnp.einsum('bqhd,bqkd->bhqk', qb, ks,
                            preferred_element_type=jnp.float32) * (HEAD_DIM ** -0.5)
        bias = table[t5_bucket(tpos[None, :, None] - idx)]
        logits = logits + bias.transpose(0, 3, 1, 2).astype(jnp.float32)
        logits = jnp.where(valid[:, None], logits, -jnp.inf)
        p = jax.nn.softmax(logits, axis=-1)
        return jnp.einsum('bhqk,bqkd->bqhd', p.astype(vs.dtype), vs)

    o = lax.map(block, (jnp.arange(nb), to_blocks(q), to_blocks(qi), to_blocks(wi)))
    o = o.swapaxes(0, 1).reshape(B, S, ODD_MIX)
    return o @ w_out


def swiglu(h, w1, w3, w2):
    return (jax.nn.silu(h @ w1) * (h @ w3)) @ w2


def moe_swiglu(h, w_router, w1, w3, w2):
    B, S, D = h.shape
    T = B * S
    A = T * TOP_K
    xt = h.reshape(T, D)
    logits = jnp.dot(xt, w_router, preferred_element_type=jnp.float32)
    top_vals, top_idx = lax.top_k(logits, TOP_K)
    gates = jax.nn.softmax(top_vals, axis=-1)
    e_flat = top_idx.reshape(-1)
    tok_flat = jnp.arange(A) // TOP_K
    order = jnp.argsort(e_flat)
    e_sorted = e_flat[order]
    counts = jnp.bincount(e_flat, length=N_EXPERTS)
    starts = jnp.cumsum(counts) - counts
    padded = (counts + MOE_BLOCK - 1) // MOE_BLOCK * MOE_BLOCK
    pends = jnp.cumsum(padded)
    dest = (pends - padded)[e_sorted] + jnp.arange(A) - starts[e_sorted]
    n_blocks = -(-A // MOE_BLOCK) + N_EXPERTS
    P = n_blocks * MOE_BLOCK
    slot_tok = jnp.full((P,), T, jnp.int32).at[dest].set(tok_flat[order])
    slot_gate = jnp.zeros((P,), jnp.float32).at[dest].set(gates.reshape(-1)[order])
    block_expert = jnp.minimum(jnp.searchsorted(pends, jnp.arange(n_blocks) * MOE_BLOCK, side='right'),
                               N_EXPERTS - 1)
    x_pad = jnp.concatenate([xt, jnp.zeros((1, D), xt.dtype)], axis=0)
    xb = x_pad[slot_tok].reshape(n_blocks, MOE_BLOCK, D)

    def expert_block(args):
        xblk, e = args
        return swiglu(xblk, w1[e], w3[e], w2[e])

    yb = lax.map(expert_block, (xb, block_expert))
    y = yb.reshape(P, D) * slot_gate[:, None].astype(yb.dtype)
    out = jnp.zeros((T + 1, D), yb.dtype).at[slot_tok].add(y)[:T]
    return out.reshape(B, S, D)


def setup_inputs(seed: int = 0) -> dict:
    key = jax.random.key(seed)
    ks = jax.random.split(key, 20)
    nrm = lambda k, shape, s: jax.random.normal(k, shape, jnp.float32) * s
    D = D_MODEL
    return {
        "x": nrm(ks[0], (BATCH, SEQ, D), 1.0),
        "c": nrm(ks[1], (BATCH, D), 1.0),
        "rel_table": nrm(ks[2], (REL_BUCKETS, REL_HEADS), 0.3),
        "w_in_even": nrm(ks[3], (N_EVEN, D, EVEN_IN), D ** -0.5),
        "w_out_even": nrm(ks[4], (N_EVEN, EVEN_MIX, D), EVEN_MIX ** -0.5 * BETA),
        "sinks": nrm(ks[5], (N_EVEN, B_HEADS), 0.5),
        "w_in_odd": nrm(ks[6], (N_ODD, D, ODD_IN), D ** -0.5),
        "w_out_odd": nrm(ks[7], (N_ODD, ODD_MIX, D), ODD_MIX ** -0.5 * BETA),
        "ffn_w1": nrm(ks[8], (N_EVEN, D, D_FF), D ** -0.5),
        "ffn_w3": nrm(ks[9], (N_EVEN, D, D_FF), D ** -0.5),
        "ffn_w2": nrm(ks[10], (N_EVEN, D_FF, D), D_FF ** -0.5 * BETA),
        "router": nrm(ks[11], (N_ODD, D, N_EXPERTS), D ** -0.5),
        "exp_w1": nrm(ks[12], (N_ODD, N_EXPERTS, D, D_FF), D ** -0.5),
        "exp_w3": nrm(ks[13], (N_ODD, N_EXPERTS, D, D_FF), D ** -0.5),
        "exp_w2": nrm(ks[14], (N_ODD, N_EXPERTS, D_FF, D), D_FF ** -0.5 * BETA),
        "ada_w": nrm(ks[15], (DEPTH, 2, D, 3 * D), 0.1 * D ** -0.5),
        "ada_b": nrm(ks[16], (DEPTH, 2, 3 * D), 0.02),
        "ln_g": 1.0 + nrm(ks[17], (DEPTH, 2, D), 0.05),
        "ln_b": nrm(ks[18], (DEPTH, 2, D), 0.02),
    }


def reference(x, c, rel_table, w_in_even, w_out_even, sinks, w_in_odd, w_out_odd,
              ffn_w1, ffn_w3, ffn_w2, router, exp_w1, exp_w3, exp_w2,
              ada_w, ada_b, ln_g, ln_b):
    for layer in range(DEPTH):
        i = layer // 2
        shift, scale, gate = ada_modulation(c, ada_w[layer, 0], ada_b[layer, 0])
        h = x * scale + shift
        if layer % 2 == 0:
            mix = even_mixer(h, w_in_even[i], w_out_even[i], rel_table, sinks[i])
        else:
            mix = dsa_mixer(h, w_in_odd[i], w_out_odd[i], rel_table)
        x = layer_norm(ALPHA * x + gate * mix, ln_g[layer, 0], ln_b[layer, 0])
        shift, scale, gate = ada_modulation(c, ada_w[layer, 1], ada_b[layer, 1])
        h = x * scale + shift
        if layer % 2 == 0:
            ff = swiglu(h, ffn_w1[i], ffn_w3[i], ffn_w2[i])
        else:
            ff = moe_swiglu(h, router[i], exp_w1[i], exp_w3[i], exp_w2[i])
        x = layer_norm(ALPHA * x + gate * ff, ln_g[layer, 1], ln_b[layer, 1])
    return x
```

```cpp
#include <hip/hip_runtime.h>
#include <cstdio>
#include <cstdint>

#ifndef PROBE_MASK
#define PROBE_MASK 0
#endif
#ifndef AM_E
#define AM_E 1.f
#endif
#ifndef AM_O
#define AM_O 1.f
#endif
#ifndef AM_F
#define AM_F 1.f
#endif
#ifndef AM_M
#define AM_M 1.f
#endif
#ifndef REPEAT_CAT
#define REPEAT_CAT -1
#endif
#define REP(c) for (int rep_ = 0; rep_ < ((REPEAT_CAT == (c)) ? 2 : 1); ++rep_)
#ifndef PROBE_DBG
#define PROBE_DBG 0
#endif
#ifndef UP_FP8_DENSE
#define UP_FP8_DENSE 0
#endif
#ifndef UP_FP8_MOE
#define UP_FP8_MOE 1
#endif
#ifndef DOWN_FP8_DENSE
#define DOWN_FP8_DENSE 1
#endif
#ifndef DOWN_FP8_MOE
#define DOWN_FP8_MOE 1
#endif
#ifndef PROJ_FP8
#define PROJ_FP8 1
#endif
#ifndef MK_SPLIT
#define MK_SPLIT 0
#endif

namespace pg8 {
#define PG8_LAS __attribute__((address_space(3)))
typedef unsigned short bf16_t;
typedef short bf16x8 __attribute__((ext_vector_type(8)));
typedef float f32x4 __attribute__((ext_vector_type(4)));
typedef unsigned u32x4 __attribute__((ext_vector_type(4)));
constexpr int BM = 256, BK = 64, HALF = 128, HTB = HALF * BK * 2, STAGE_BYTES = 8 * HTB, NXCD = 8, WGM = 8;

__host__ __device__ __forceinline__ int lds_byte(int r, int c) { const int st = (r >> 4) * 2 + (c >> 5), rr = r & 15, cc = c & 31, ob = rr * 64 + cc * 2; return st * 1024 + (ob ^ (((ob >> 9) & 1) << 5)); }
__host__ __device__ __forceinline__ void stage_rc(int b, int& R, int& C) { const int st = b / 1024, sb = b % 1024, swz = sb ^ (((sb >> 9) & 1) << 5); R = (st >> 1) * 16 + swz / 64; C = (st & 1) * 32 + (swz % 64) / 2; }
__host__ __device__ __forceinline__ int perm32(int rho) { const int n = rho >> 4, i = rho & 15; return 8 * (i >> 2) + 4 * n + (i & 3); }

struct Unit { int pm, pn; };
struct Gemm { const bf16_t* A; const bf16_t* Bt; int M, N, K; };

struct GroupOrder {
    int nM, nN, nwg, G, c; const PG8_LAS int* us;
    __device__ __forceinline__ void init(int nM_, int nN_, int G_, int c_, const PG8_LAS int* us_) { nM = nM_; nN = nN_; nwg = nM * nN; G = G_; c = c_; us = us_; }
    __device__ __forceinline__ bool next(int i, Unit& u) const {
        const long L = (long)i * G + c; if (L >= nwg) return false;
        int wgid = (int)L; { const int q = nwg / NXCD, r = nwg % NXCD, xcd = wgid % NXCD, off = wgid / NXCD; wgid = (xcd < r ? xcd * (q + 1) : r * (q + 1) + (xcd - r) * q) + off; }
        const int nig = WGM * nN, gid = wgid / nig, fm = gid * WGM, gsz = (nM - fm) < WGM ? (nM - fm) : WGM;
        const int pm = fm + ((wgid % nig) % gsz), pn = (wgid % nig) / gsz;
        int e = 0;
#pragma unroll
        for (int k = 1; k < 8; ++k) e += (us[k] <= pm) ? 1 : 0;
        u.pm = pm; u.pn = e * nN + pn; return true;
    }
    __device__ __forceinline__ void a_ready(const Unit&) const {}
    __device__ __forceinline__ void done(const Unit&) const {}
};

__device__ __forceinline__ unsigned cvt_pk_bf16(float lo, float hi) { unsigned r; asm volatile("v_cvt_pk_bf16_f32 %0, %1, %2" : "=v"(r) : "v"(lo), "v"(hi)); return r; }

struct EpiOut {
    static constexpr bool PERM = true, AFTER_DRAIN = false;
    int mode; void* P; int ldc; int nNe; const void* X; int xf32; const float* gate; float osc;
    __device__ __forceinline__ void operator()(const f32x4 (&acc)[2][2][4][2], const Unit& u, int wr, int wc, int fr, int fq) const {
        const int row0 = u.pm * BM + wr * 64 + fr; const int colt = (u.pn % nNe) * BM + wc * 32 + 8 * fq;
        if (mode == 1) {
#pragma unroll
            for (int ai = 0; ai < 2; ++ai)
#pragma unroll
                for (int m = 0; m < 4; ++m) { bf16_t* rowp = (bf16_t*)P + (size_t)(row0 + ai * HALF + m * 16) * ldc + colt;
#pragma unroll
                    for (int bj = 0; bj < 2; ++bj) { const f32x4 v0 = acc[ai][bj][m][0] * osc, v1 = acc[ai][bj][m][1] * osc;
                        u32x4 w; w.x = cvt_pk_bf16(v0[0], v0[1]); w.y = cvt_pk_bf16(v0[2], v0[3]); w.z = cvt_pk_bf16(v1[0], v1[1]); w.w = cvt_pk_bf16(v1[2], v1[3]);
                        *(u32x4*)(rowp + bj * HALF) = w;
 } }
        } else {
            const float* gp = gate + (size_t)((u.pm * BM) >> 13) * 1024 + colt;
            f32x4 gv[2][2];
#pragma unroll
            for (int bj = 0; bj < 2; ++bj)
#pragma unroll
                for (int n = 0; n < 2; ++n) gv[bj][n] = *(const f32x4*)(gp + bj * HALF + 4 * n);
            const float am = osc;
#pragma unroll
            for (int ai = 0; ai < 2; ++ai)
#pragma unroll
                for (int m = 0; m < 4; ++m) { const size_t ro = (size_t)(row0 + ai * HALF + m * 16) * 1024 + colt;
#pragma unroll
                    for (int bj = 0; bj < 2; ++bj) { f32x4 x0, x1;
                        if (xf32) { x0 = *(const f32x4*)((const float*)X + ro + bj * HALF); x1 = *(const f32x4*)((const float*)X + ro + bj * HALF + 4); }
                        else { const u32x4 xw = *(const u32x4*)((const bf16_t*)X + ro + bj * HALF);
                            x0 = (f32x4){__builtin_bit_cast(float, xw.x << 16), __builtin_bit_cast(float, xw.x & 0xffff0000u), __builtin_bit_cast(float, xw.y << 16), __builtin_bit_cast(float, xw.y & 0xffff0000u)};
                            x1 = (f32x4){__builtin_bit_cast(float, xw.z << 16), __builtin_bit_cast(float, xw.z & 0xffff0000u), __builtin_bit_cast(float, xw.w << 16), __builtin_bit_cast(float, xw.w & 0xffff0000u)}; }
                        const f32x4 y0 = x0 * 1.681792830507429f + gv[bj][0] * (acc[ai][bj][m][0] * am), y1 = x1 * 1.681792830507429f + gv[bj][1] * (acc[ai][bj][m][1] * am);
                        u32x4 w; w.x = cvt_pk_bf16(y0[0], y0[1]); w.y = cvt_pk_bf16(y0[2], y0[3]); w.z = cvt_pk_bf16(y1[0], y1[1]); w.w = cvt_pk_bf16(y1[2], y1[3]);
                        *(u32x4*)((bf16_t*)P + ro + bj * HALF) = w; } }
        }
    }
};
struct EpiSwiGLU {
    static constexpr bool PERM = true, AFTER_DRAIN = false;
    bf16_t* U; int ldc; int nNe; float* dbg; float sc; int o8;
    __device__ __forceinline__ void operator()(const f32x4 (&acc)[2][2][4][2], const Unit& u, int wr, int wc, int fr, int fq) const {
        const int row0 = u.pm * BM + wr * 64 + fr; const int colt = (u.pn % nNe) * HALF + wc * 32 + 8 * fq;
#pragma unroll
        for (int ai = 0; ai < 2; ++ai)
#pragma unroll
            for (int m = 0; m < 4; ++m) { float r[8];
#pragma unroll
                for (int n = 0; n < 2; ++n)
#pragma unroll
                    for (int e = 0; e < 4; ++e) { const float a = acc[ai][0][m][n][e] * sc, b = acc[ai][1][m][n][e] * sc;
                        const float s = a * __builtin_amdgcn_rcpf(1.f + __builtin_amdgcn_exp2f(-1.4426950408889634f * a)); r[4 * n + e] = s * b; }
                if (o8) { typedef unsigned u32x2_ __attribute__((ext_vector_type(2))); u32x2_ w8;
                    int p0 = __builtin_amdgcn_cvt_pk_fp8_f32(r[0], r[1], 0, false); p0 = __builtin_amdgcn_cvt_pk_fp8_f32(r[2], r[3], p0, true);
                    int p1 = __builtin_amdgcn_cvt_pk_fp8_f32(r[4], r[5], 0, false); p1 = __builtin_amdgcn_cvt_pk_fp8_f32(r[6], r[7], p1, true);
                    w8.x = (unsigned)p0; w8.y = (unsigned)p1; *(u32x2_*)((unsigned char*)U + (size_t)(row0 + ai * HALF + m * 16) * ldc + colt) = w8; }
                else {
                u32x4 w; w.x = cvt_pk_bf16(r[0], r[1]); w.y = cvt_pk_bf16(r[2], r[3]); w.z = cvt_pk_bf16(r[4], r[5]); w.w = cvt_pk_bf16(r[6], r[7]);
                *(u32x4*)(U + (size_t)(row0 + ai * HALF + m * 16) * ldc + colt) = w; }
                if (dbg) { float t_ = 0.f;
#pragma unroll
                    for (int k = 0; k < 8; ++k) t_ += __builtin_fabsf(r[k]);
#pragma unroll
                    for (int o = 1; o < 64; o <<= 1) t_ += __shfl_xor(t_, o);
                    if ((fr | fq) == 0) atomicAdd(dbg, t_ * (1.f / (65536.f * 3584.f))); } }
    }
};

template <class Epi, class Sched, bool ALIGN_EPI = false, bool SP2 = false, bool FP8 = false>
__device__ __forceinline__ void gemm_phase(PG8_LAS unsigned char* lds, const Gemm g, const Sched& S, const Epi& E, const int tid) {
    const int wid = __builtin_amdgcn_readfirstlane(tid >> 6), lane = tid & 63, wr = wid >> 2, wc = wid & 3, fr = lane & 15, fq = lane >> 4;
    const int K = g.K, nt = K / BK;
    unsigned voffA[2], voffB[2];
#pragma unroll
    for (int i = 0; i < 2; ++i) { int R, C; stage_rc(tid * 16 + i * 8192, R, C); const int Rb = Epi::PERM ? ((R & ~31) + perm32(R & 31)) : R;
        voffA[i] = (unsigned)(R * K + C) * 2u; voffB[i] = (unsigned)(Rb * K + C) * 2u; }
    const size_t kstep = (size_t)(BK * 2);
    const size_t hstep = (size_t)HALF * K * 2;
    const size_t tstep = 2 * hstep;
    const unsigned ldsw = (unsigned)wid * 1024u;
    const int aoff = lds_byte(wr * 64 + fr, fq * 8), boff = lds_byte(wc * 32 + fr, fq * 8);
#define PG8_SA(b, h) (((b) * 2 + (h)) * HTB)
#define PG8_SB(b, h) ((4 + (b) * 2 + (h)) * HTB)
#define PG8_STAGE(bufoff, gbase, voff) do { _Pragma("unroll") for (int _i = 0; _i < 2; ++_i) \
        __builtin_amdgcn_global_load_lds((const unsigned*)((const char*)(gbase) + (voff)[_i]), (PG8_LAS unsigned*)(lds + (bufoff) + ldsw + _i * 8192), 16, 0, 0); } while (0)
#define PG8_LDA(dst, b, h) do { _Pragma("unroll") for (int m = 0; m < 4; ++m) { if constexpr (FP8) { dst##8[m].lo = *(const PG8_LAS v4i_*)(lds + PG8_SA(b, h) + aoff + m * 2048); dst##8[m].hi = *(const PG8_LAS v4i_*)(lds + PG8_SA(b, h) + aoff + m * 2048 + 1024); } \
        else { _Pragma("unroll") for (int k = 0; k < 2; ++k) dst[m][k] = *(const PG8_LAS bf16x8*)(lds + PG8_SA(b, h) + aoff + m * 2048 + k * 1024); } } } while (0)
#define PG8_LDB(dst, b, h) do { _Pragma("unroll") for (int n = 0; n < 2; ++n) { if constexpr (FP8) { dst##8[n].lo = *(const PG8_LAS v4i_*)(lds + PG8_SB(b, h) + boff + n * 2048); dst##8[n].hi = *(const PG8_LAS v4i_*)(lds + PG8_SB(b, h) + boff + n * 2048 + 1024); } \
        else { _Pragma("unroll") for (int k = 0; k < 2; ++k) dst[n][k] = *(const PG8_LAS bf16x8*)(lds + PG8_SB(b, h) + boff + n * 2048 + k * 1024); } } } while (0)
#define PG8_MMA(ai, bj, At, Bt) do { __builtin_amdgcn_s_setprio(1); _Pragma("unroll") for (int m = 0; m < 4; ++m) _Pragma("unroll") for (int n = 0; n < 2; ++n) { \
        if constexpr (FP8) asm volatile("v_mfma_scale_f32_16x16x128_f8f6f4 %0, %1, %2, %0, %3, %3 op_sel_hi:[0,0,0]" : "+v"(acc[ai][bj][m][n]) : "v"(Bt##8[n]), "v"(At##8[m]), "v"(sc127)); \
        else { _Pragma("unroll") for (int k = 0; k < 2; ++k) acc[ai][bj][m][n] = __builtin_amdgcn_mfma_f32_16x16x32_bf16(Bt[n][k], At[m][k], acc[ai][bj][m][n], 0, 0, 0); } } \
        __builtin_amdgcn_s_setprio(0); } while (0)
#define PG8_WAIT_V(n) asm volatile("s_waitcnt vmcnt(" #n ")" ::: "memory")
#define PG8_WAIT_L(n) asm volatile("s_waitcnt lgkmcnt(" #n ")" ::: "memory")
#define PG8_BAR __builtin_amdgcn_s_barrier()
#define PG8_SCHED __builtin_amdgcn_sched_barrier(0)
    Unit cur, nxt; int ui = 0;
    if (!S.next(0, cur)) return;
    f32x4 acc[2][2][4][2];
#pragma unroll
    for (int a = 0; a < 2; ++a)
#pragma unroll
        for (int b = 0; b < 2; ++b)
#pragma unroll
            for (int m = 0; m < 4; ++m)
#pragma unroll
                for (int n = 0; n < 2; ++n) acc[a][b][m][n] = (f32x4){0.f, 0.f, 0.f, 0.f};
    typedef int v4i_ __attribute__((ext_vector_type(4))); typedef int v8i_ __attribute__((ext_vector_type(8)));
    bf16x8 At[4][2], B0[2][2], B1[2][2]; v8i_ At8[4], B08[2], B18[2]; const int sc127 = 127;
    const char* cA = (const char*)g.A + (size_t)cur.pm * tstep; const char* cB = (const char*)g.Bt + (size_t)cur.pn * tstep;
    S.a_ready(cur);
    if constexpr (SP2) {
        PG8_STAGE(PG8_SB(0, 0), cB, voffB); PG8_STAGE(PG8_SB(0, 1), cB + hstep, voffB); PG8_STAGE(PG8_SA(0, 0), cA, voffA); PG8_STAGE(PG8_SA(0, 1), cA + hstep, voffA);
        if (wr == 1) PG8_BAR;
        PG8_WAIT_V(2); PG8_BAR;
        PG8_STAGE(PG8_SB(1, 0), cB + kstep, voffB); PG8_STAGE(PG8_SA(1, 0), cA + kstep, voffA); PG8_STAGE(PG8_SB(1, 1), cB + hstep + kstep, voffB);
        PG8_WAIT_V(6); PG8_BAR;
    } else {
        PG8_STAGE(PG8_SB(0, 0), cB, voffB); PG8_STAGE(PG8_SA(0, 0), cA, voffA); PG8_STAGE(PG8_SB(0, 1), cB + hstep, voffB); PG8_STAGE(PG8_SA(0, 1), cA + hstep, voffA);
        if (wr == 1) PG8_BAR;
        PG8_WAIT_V(4); PG8_BAR;
        PG8_STAGE(PG8_SB(1, 0), cB + kstep, voffB); PG8_STAGE(PG8_SA(1, 0), cA + kstep, voffA); PG8_STAGE(PG8_SB(1, 1), cB + hstep + kstep, voffB);
        PG8_WAIT_V(6); PG8_BAR;
    }
    for (;;) {
        const bool has_next = S.next(ui + 1, nxt);
        const char* nA = has_next ? (const char*)g.A + (size_t)nxt.pm * tstep : cA; const char* nB = has_next ? (const char*)g.Bt + (size_t)nxt.pn * tstep : cB;
        for (int t = 0; t < nt; t += 2) {
            const bool last = (t == nt - 2);
            const char* a1 = cA + (size_t)(t + 1) * kstep;
            const char* a2 = last ? nA : cA + (size_t)(t + 2) * kstep; const char* b2 = last ? nB : cB + (size_t)(t + 2) * kstep;
            const char* a3 = a2 + kstep; const char* b3 = b2 + kstep;
            if (last && has_next) S.a_ready(nxt);
            if constexpr (SP2) {
            PG8_LDB(B0, 0, 0); PG8_LDB(B1, 0, 1); PG8_SCHED; PG8_LDA(At, 0, 0); PG8_STAGE(PG8_SA(1, 1), a1 + hstep, voffA);
            PG8_WAIT_V(8); PG8_WAIT_L(0); PG8_BAR; PG8_MMA(0, 0, At, B0); PG8_MMA(0, 1, At, B1); PG8_BAR; PG8_SCHED;
            PG8_LDA(At, 0, 1); PG8_STAGE(PG8_SB(0, 0), b2, voffB); PG8_STAGE(PG8_SB(0, 1), b2 + hstep, voffB); PG8_STAGE(PG8_SA(0, 0), a2, voffA);
            PG8_WAIT_V(8); PG8_WAIT_L(0); PG8_BAR; PG8_MMA(1, 0, At, B0); PG8_MMA(1, 1, At, B1); PG8_BAR; PG8_SCHED;
            PG8_LDB(B0, 1, 0); PG8_LDB(B1, 1, 1); PG8_SCHED; PG8_LDA(At, 1, 0); PG8_STAGE(PG8_SA(0, 1), a2 + hstep, voffA);
            PG8_WAIT_V(8); PG8_WAIT_L(0); PG8_BAR; PG8_MMA(0, 0, At, B0); PG8_MMA(0, 1, At, B1); PG8_BAR; PG8_SCHED;
            PG8_LDA(At, 1, 1); PG8_STAGE(PG8_SB(1, 0), b3, voffB); PG8_STAGE(PG8_SB(1, 1), b3 + hstep, voffB); PG8_STAGE(PG8_SA(1, 0), a3, voffA);
            PG8_WAIT_V(8); PG8_WAIT_L(0); PG8_BAR; PG8_MMA(1, 0, At, B0); PG8_MMA(1, 1, At, B1); PG8_BAR; PG8_SCHED;
            } else {
            PG8_LDB(B0, 0, 0); PG8_SCHED; PG8_LDA(At, 0, 0); PG8_STAGE(PG8_SA(1, 1), a1 + hstep, voffA);
            PG8_WAIT_L(8); PG8_BAR; PG8_WAIT_L(0); PG8_MMA(0, 0, At, B0); PG8_BAR; PG8_SCHED;
            PG8_LDB(B1, 0, 1); PG8_STAGE(PG8_SB(0, 0), b2, voffB);
            PG8_BAR; PG8_WAIT_L(0); PG8_MMA(0, 1, At, B1); PG8_BAR;
            PG8_LDA(At, 0, 1); PG8_STAGE(PG8_SA(0, 0), a2, voffA);
            PG8_BAR; PG8_WAIT_L(0); PG8_MMA(1, 0, At, B0); PG8_BAR; PG8_SCHED;
            PG8_STAGE(PG8_SB(0, 1), b2 + hstep, voffB);
            PG8_WAIT_V(6); PG8_BAR; PG8_MMA(1, 1, At, B1); PG8_BAR;
            PG8_LDB(B0, 1, 0); PG8_SCHED; PG8_LDA(At, 1, 0); PG8_STAGE(PG8_SA(0, 1), a2 + hstep, voffA);
            PG8_WAIT_L(8); PG8_BAR; PG8_WAIT_L(0); PG8_MMA(0, 0, At, B0); PG8_BAR; PG8_SCHED;
            PG8_LDB(B1, 1, 1); PG8_STAGE(PG8_SB(1, 0), b3, voffB);
            PG8_BAR; PG8_WAIT_L(0); PG8_MMA(0, 1, At, B1); PG8_BAR;
            PG8_LDA(At, 1, 1); PG8_STAGE(PG8_SA(1, 0), a3, voffA);
            PG8_BAR; PG8_WAIT_L(0); PG8_MMA(1, 0, At, B0); PG8_BAR; PG8_SCHED;
            PG8_STAGE(PG8_SB(1, 1), b3 + hstep, voffB);
            PG8_WAIT_V(6); PG8_BAR; PG8_MMA(1, 1, At, B1); PG8_BAR;
            }
        }
        if constexpr (ALIGN_EPI) { if (wr == 0) PG8_BAR; }
        if constexpr (!Epi::AFTER_DRAIN) { E(acc, cur, wr, wc, fr, fq); S.done(cur); }
        if (!has_next) break;
#pragma unroll
        for (int a = 0; a < 2; ++a)
#pragma unroll
            for (int b = 0; b < 2; ++b)
#pragma unroll
                for (int m = 0; m < 4; ++m)
#pragma unroll
                    for (int n = 0; n < 2; ++n) acc[a][b][m][n] = (f32x4){0.f, 0.f, 0.f, 0.f};
        cur = nxt; cA = nA; cB = nB; ++ui;
        if constexpr (ALIGN_EPI) { if (wr == 1) PG8_BAR; }
    }
    PG8_WAIT_V(0);
    if constexpr (!ALIGN_EPI) { if (wr == 0) PG8_BAR; }
    PG8_BAR;
#undef PG8_SA
#undef PG8_SB
#undef PG8_STAGE
#undef PG8_LDA
#undef PG8_LDB
#undef PG8_MMA
#undef PG8_WAIT_V
#undef PG8_WAIT_L
#undef PG8_BAR
#undef PG8_SCHED
}
}

constexpr int NB = 4, SEQ = 8192, T = NB * SEQ, D = 1024, FF = 3584, NE = 8, DEPTH = 4;
constexpr int EV_IN = 2304, OD_IN = 1736, OD_INP = 1792;
constexpr int PMAX = 2 * T + NE * 256;
constexpr float ALPHA = 1.681792830507429f;
constexpr float LN_EPS = 1e-5f;
constexpr float LOG2E = 1.4426950408889634f, C2 = 0.125f * 1.4426950408889634f;
constexpr float WIS = 0.04419417382415922f;
constexpr float NEGF = -1e30f;
constexpr int NWAVES = 8;

constexpr size_t MiB = 1u << 20;
constexpr size_t WS_CTL = 0, CTL_ZERO_BYTES = 64 * 1024;
constexpr size_t WS_MOD = 1 * MiB;
constexpr size_t WS_CNTG = WS_MOD + 512 * 1024;
constexpr size_t WS_CNTW = WS_CNTG + 16 * 1024;
constexpr size_t WS_RT_E = 128 * 1024, WS_RT_G = 384 * 1024, WS_RT_S = 640 * 1024;
constexpr size_t WS_ROUTE_UNUSED = 0;
constexpr size_t WS_WINE = 2 * MiB, WS_WOE = 11 * MiB, WS_WINO = 15 * MiB, WS_WOO = 22 * MiB;
constexpr size_t WS_W13 = 26 * MiB, WS_W2 = 138 * MiB;
constexpr size_t WS_H = 194 * MiB;
constexpr size_t WS_AR = 258 * MiB;
constexpr size_t WS_QKV = WS_AR;
constexpr size_t WS_IDX = WS_AR + 112 * MiB;
constexpr size_t WS_O = WS_AR + 144 * MiB;
constexpr size_t WS_PART = WS_AR + 208 * MiB;
constexpr size_t WS_LSE = WS_AR + 304 * MiB;
constexpr size_t WS_SCR = WS_AR + 208 * MiB;
constexpr size_t WS_U = WS_AR;
constexpr size_t WS_XB = WS_AR;
constexpr size_t WS_UM = WS_AR + 132 * MiB;
constexpr size_t WS_XH = WS_UM + (size_t)PMAX * FF * 2;
constexpr size_t WS_END = WS_XH + (size_t)T * D * 2;
static_assert(WS_END <= 920 * MiB, "d_ws map");

constexpr int RING_BYTES = 131072;
constexpr int MISC_OFF = RING_BYTES + 320;
constexpr int LDS_BYTES = 147456;

#define GAS __attribute__((address_space(1)))
#define LAS __attribute__((address_space(3)))
typedef unsigned short bf16;
typedef unsigned v4u __attribute__((ext_vector_type(4)));
typedef unsigned v2u __attribute__((ext_vector_type(2)));
typedef float f32x4 __attribute__((ext_vector_type(4)));
typedef float f32x16 __attribute__((ext_vector_type(16)));
typedef short bf16x8 __attribute__((ext_vector_type(8)));
typedef short s16x4 __attribute__((ext_vector_type(4)));
typedef GAS unsigned gu32;
#define RLX_AGENT __ATOMIC_RELAXED, __HIP_MEMORY_SCOPE_AGENT
#define LDS_WAIT() asm volatile("s_waitcnt lgkmcnt(0)" ::: "memory")
#define VM_WAIT() asm volatile("s_waitcnt vmcnt(0)" ::: "memory")
#define CBAR() asm volatile("" ::: "memory")
__device__ __forceinline__ unsigned f2bf(float f) { unsigned u = __builtin_bit_cast(unsigned, f); return (u + 0x7fffu + ((u >> 16) & 1u)) >> 16; }
__device__ __forceinline__ unsigned pk2(float lo, float hi) { return f2bf(lo) | (f2bf(hi) << 16); }
__device__ __forceinline__ unsigned pk4_fp8(float a, float b, float c, float d) { int p = __builtin_amdgcn_cvt_pk_fp8_f32(a, b, 0, false); p = __builtin_amdgcn_cvt_pk_fp8_f32(c, d, p, true); return (unsigned)p; }
__device__ __forceinline__ float bf2f(unsigned b) { return __builtin_bit_cast(float, b << 16); }
__device__ __forceinline__ float bflo(unsigned w) { return __builtin_bit_cast(float, w << 16); }
__device__ __forceinline__ float bfhi(unsigned w) { return __builtin_bit_cast(float, w & 0xffff0000u); }

#define XB_TMO      128
#define XB_XCNT(j)  (256  + 64 * (j))
#define XB_XSUB(j)  (1280 + 64 * (j))
#define XB_XGEN(j)  (2304 + 64 * (j))
#define XB_TOP      3328
#define XB_TOPGEN   3392
#define XCD_BAR_WORDS 3456
#define XB_SPIN_CAP (1u << 20)
__device__ __forceinline__ unsigned xb_ld(unsigned* p)              { return __hip_atomic_load(p, __ATOMIC_RELAXED, __HIP_MEMORY_SCOPE_AGENT); }
__device__ __forceinline__ unsigned xb_add(unsigned* p, unsigned v) { return __hip_atomic_fetch_add(p, v, __ATOMIC_RELAXED, __HIP_MEMORY_SCOPE_AGENT); }
__device__ __forceinline__ unsigned xb_xcc_id() { return (unsigned)__builtin_amdgcn_s_getreg((3 << 11) | 20) & 0xFu; }
#define XB_SPIN(cond, bar) do { unsigned _sp = 0; while (cond) { __builtin_amdgcn_s_sleep(1); \
    if ((++_sp & 255u) == 0u) { if (xb_ld(&(bar)[XB_TMO])) break; if (_sp > XB_SPIN_CAP) { atomicAdd(&(bar)[XB_TMO], 1u); break; } } } } while (0)
struct XcdBarrier { unsigned* bar; unsigned x; volatile LAS unsigned* st; };
__device__ __forceinline__ XcdBarrier xcd_barrier_post(unsigned* bar, volatile LAS unsigned* st) {
    XcdBarrier b; b.bar = bar; b.x = xb_xcc_id(); b.st = st;
    if (threadIdx.x == 0) (void)xb_add(&bar[XB_XCNT(b.x)], 1u);
    return b;
}
__device__ __forceinline__ void xcd_barrier_complete(unsigned* bar, unsigned x, unsigned& nloc, unsigned& nx) {
    const unsigned G = gridDim.x * gridDim.y * gridDim.z;
    unsigned sum, cnt, mine, sp = 0u;
    for (;;) {
        sum = 0u; cnt = 0u; mine = 0u;
#pragma unroll
        for (unsigned j = 0; j < 16; ++j) { const unsigned c = xb_ld(&bar[XB_XCNT(j)]); sum += c; cnt += (c > 0u) ? 1u : 0u; mine = (j == x) ? c : mine; }
        if (sum == G) break;
        __builtin_amdgcn_s_sleep(1);
        if ((++sp & 255u) == 0u) { if (xb_ld(&bar[XB_TMO])) break; if (sp > XB_SPIN_CAP) { atomicAdd(&bar[XB_TMO], 1u); break; } }
    }
    nloc = mine > 0u ? mine : 1u; nx = cnt > 0u ? cnt : 1u;
}
__device__ __forceinline__ void xcd_barrier(const XcdBarrier& b) {
    asm volatile("s_waitcnt vmcnt(0)" ::: "memory");
    __syncthreads();
    if (threadIdx.x == 0) {
        unsigned* bar = b.bar;
        __builtin_amdgcn_s_waitcnt(0);
        unsigned nloc = b.st[0], nx = b.st[1];
        if (nloc == 0u) { xcd_barrier_complete(bar, b.x, nloc, nx); b.st[0] = nloc; b.st[1] = nx; }
        const unsigned old = xb_add(&bar[XB_XSUB(b.x)], 1u);
        const unsigned gen = old / nloc;
        if (old + 1u == (gen + 1u) * nloc) {
            __builtin_amdgcn_fence(__ATOMIC_RELEASE, "agent");
            asm volatile("s_waitcnt vmcnt(0)" ::: "memory");
            const unsigned og = xb_add(&bar[XB_TOP], 1u);
            const unsigned tg = og / nx;
            if (og + 1u == (tg + 1u) * nx) xb_add(&bar[XB_TOPGEN], 1u);
            else XB_SPIN(xb_ld(&bar[XB_TOPGEN]) == tg, bar);
            __builtin_amdgcn_fence(__ATOMIC_ACQUIRE, "agent");
            xb_add(&bar[XB_XGEN(b.x)], 1u);
            asm volatile("s_waitcnt vmcnt(0)" ::: "memory");
        } else {
            XB_SPIN(xb_ld(&bar[XB_XGEN(b.x)]) == gen, bar);
            __builtin_amdgcn_fence(__ATOMIC_ACQUIRE, "agent");
            asm volatile("s_waitcnt vmcnt(0)" ::: "memory");
        }
    }
    __syncthreads();
}

struct Frame {
    LAS unsigned char* lds;
    int tid, lane, wave, G, bid;
    float* XR; unsigned char* ws;
};
constexpr size_t WS_DBG = 60 * 1024;
__device__ __forceinline__ void dbg_add(Frame& F, float v) { atomicAdd((float*)(F.ws + WS_DBG), v); }
template <int K> __device__ __forceinline__ const float* inp() {
    unsigned long long v; const unsigned long long kp = (unsigned long long)__builtin_amdgcn_kernarg_segment_ptr();
    asm volatile("s_load_dwordx2 %0, %1, %2\n\ts_waitcnt lgkmcnt(0)" : "=s"(v) : "s"(kp), "n"(K * 8));
    return (const float*)v;
}
enum { I_X = 0, I_C, I_REL, I_W_IN_E, I_W_OUT_E, I_SINKS, I_W_IN_O, I_W_OUT_O, I_F_W1, I_F_W3, I_F_W2, I_ROUTER, I_E_W1, I_E_W3, I_E_W2, I_ADA_W, I_ADA_B, I_LN_G, I_LN_B };
__device__ __forceinline__ float sum32(float v) { const auto r = __builtin_amdgcn_permlane32_swap(__builtin_bit_cast(unsigned, v), __builtin_bit_cast(unsigned, v), false, false); const unsigned a = r[0], b = r[1]; return __builtin_bit_cast(float, a) + __builtin_bit_cast(float, b); }
__device__ __forceinline__ float max32(float v) { const auto r = __builtin_amdgcn_permlane32_swap(__builtin_bit_cast(unsigned, v), __builtin_bit_cast(unsigned, v), false, false); const unsigned a = r[0], b = r[1]; return fmaxf(__builtin_bit_cast(float, a), __builtin_bit_cast(float, b)); }
__device__ __forceinline__ float sum16(float v) { const auto r = __builtin_amdgcn_permlane16_swap(__builtin_bit_cast(unsigned, v), __builtin_bit_cast(unsigned, v), false, false); const unsigned a = r[0], b = r[1]; return __builtin_bit_cast(float, a) + __builtin_bit_cast(float, b); }
__device__ __forceinline__ float max16(float v) { const auto r = __builtin_amdgcn_permlane16_swap(__builtin_bit_cast(unsigned, v), __builtin_bit_cast(unsigned, v), false, false); const unsigned a = r[0], b = r[1]; return fmaxf(__builtin_bit_cast(float, a), __builtin_bit_cast(float, b)); }
template <int CTRL> __device__ __forceinline__ float dpp_f(float v) { return __builtin_bit_cast(float, __builtin_amdgcn_update_dpp(0, __builtin_bit_cast(int, v), CTRL, 0xf, 0xf, true)); }
__device__ __forceinline__ float wave_sum(float v) {
    v += dpp_f<0xB1>(v);
    v += dpp_f<0x4E>(v);
    v += dpp_f<0x141>(v);
    v += dpp_f<0x140>(v);
    v = sum16(v); v = sum32(v);
    return v;
}
__device__ __forceinline__ float wave_max(float v) {
#pragma unroll
    for (int o = 1; o < 64; o <<= 1) v = fmaxf(v, __shfl_xor(v, o));
    return v;
}
__device__ __forceinline__ int crow(int r, int hi) { return (r & 3) + 8 * (r >> 2) + 4 * hi; }
__device__ __forceinline__ int t5_bucket(int n) {
    if (n < 16) return n < 0 ? 0 : n;
    int k = 0;
    k += n >= 22; k += n >= 30; k += n >= 40; k += n >= 54; k += n >= 73; k += n >= 99; k += n >= 134; k += n >= 182;
    k += n >= 246; k += n >= 332; k += n >= 450; k += n >= 609; k += n >= 825; k += n >= 1117; k += n >= 1513;
    return 16 + k;
}
__device__ __forceinline__ s16x4 vtr(LAS const unsigned char* p) { typedef short v4i16_t __attribute__((ext_vector_type(4))); return __builtin_bit_cast(s16x4, __builtin_amdgcn_ds_read_tr16_b64_v4i16((LAS v4i16_t*)p)); }

__device__ __forceinline__ void tr_item(const float* W, int K, int N, bf16* WT, int drow0, LAS float* scr, int k0, int n0, int lane) {
    const int col = n0 + 4 * (lane & 7);
    f32x4 ld[8];
#pragma unroll
    for (int i = 0; i < 8; ++i) { const int kk = 8 * i + (lane >> 3); ld[i] = col < N ? *(const f32x4*)(W + (size_t)(k0 + kk) * N + col) : (f32x4){0.f, 0.f, 0.f, 0.f}; }
#pragma unroll
    for (int i = 0; i < 8; ++i) { const int kk = 8 * i + (lane >> 3); LAS float* d = scr + kk * 33 + 4 * (lane & 7); d[0] = ld[i].x; d[1] = ld[i].y; d[2] = ld[i].z; d[3] = ld[i].w; }
    LDS_WAIT(); CBAR();
    const int c = lane & 7;
#pragma unroll
    for (int j = 0; j < 4; ++j) { const int n = (lane >> 3) + 8 * j; const LAS float* s = scr + (8 * c) * 33 + n;
        v4u o; o.x = pk2(s[0 * 33], s[1 * 33]); o.y = pk2(s[2 * 33], s[3 * 33]); o.z = pk2(s[4 * 33], s[5 * 33]); o.w = pk2(s[6 * 33], s[7 * 33]);
        *(GAS v4u*)(WT + (size_t)(drow0 + n) * K + k0 + 8 * c) = o; }
    LDS_WAIT(); CBAR();
}
__device__ __forceinline__ void tr_item8(const float* W, int K, int N, unsigned char* WT, int drow0, LAS float* scr, int k0, int n0, int lane, float wsc) {
    const int col = n0 + 4 * (lane & 7);
    f32x4 ld[8];
#pragma unroll
    for (int i = 0; i < 8; ++i) { const int kk = 8 * i + (lane >> 3); ld[i] = col < N ? *(const f32x4*)(W + (size_t)(k0 + kk) * N + col) : (f32x4){0.f, 0.f, 0.f, 0.f}; }
#pragma unroll
    for (int i = 0; i < 8; ++i) { const int kk = 8 * i + (lane >> 3); LAS float* d = scr + kk * 33 + 4 * (lane & 7); d[0] = ld[i].x * wsc; d[1] = ld[i].y * wsc; d[2] = ld[i].z * wsc; d[3] = ld[i].w * wsc; }
    LDS_WAIT(); CBAR();
    const int c = lane & 3;
#pragma unroll
    for (int j = 0; j < 2; ++j) { const int n = (lane >> 2) + 16 * j; const LAS float* s = scr + (16 * c) * 33 + n;
        v4u o; o.x = pk4_fp8(s[0 * 33], s[1 * 33], s[2 * 33], s[3 * 33]); o.y = pk4_fp8(s[4 * 33], s[5 * 33], s[6 * 33], s[7 * 33]);
        o.z = pk4_fp8(s[8 * 33], s[9 * 33], s[10 * 33], s[11 * 33]); o.w = pk4_fp8(s[12 * 33], s[13 * 33], s[14 * 33], s[15 * 33]);
        *(GAS v4u*)(WT + (size_t)(drow0 + n) * K + k0 + 16 * c) = o; }
    LDS_WAIT(); CBAR();
}
__device__ __forceinline__ void conv_small(Frame& F) {
    LAS float* scr = (LAS float*)(F.lds + F.wave * 16384);
    const int gw = F.bid * NWAVES + F.wave, NGW = F.G * NWAVES;
    constexpr int I_IE = 16 * 72, I_O = 16 * 32, I_IO = 16 * 56, PER = I_IE + I_O + I_IO + I_O;
    for (int it = gw; it < 2 * PER; it += NGW) {
        const int i = it / PER; int r = it % PER;
        if (r < I_IE) { if (PROJ_FP8) tr_item8(inp<I_W_IN_E>() + (size_t)i * D * EV_IN, D, EV_IN, (unsigned char*)(F.ws + WS_WINE) + (size_t)i * EV_IN * D, 32 * (r % 72), scr, 64 * (r / 72), 32 * (r % 72), F.lane, 32.f); else tr_item(inp<I_W_IN_E>() + (size_t)i * D * EV_IN, D, EV_IN, (bf16*)(F.ws + WS_WINE) + (size_t)i * EV_IN * D, 32 * (r % 72), scr, 64 * (r / 72), 32 * (r % 72), F.lane); continue; } r -= I_IE;
        if (r < I_O) { if (PROJ_FP8) tr_item8(inp<I_W_OUT_E>() + (size_t)i * D * D, D, D, (unsigned char*)(F.ws + WS_WOE) + (size_t)i * D * D, 32 * (r % 32), scr, 64 * (r / 32), 32 * (r % 32), F.lane, 64.f); else tr_item(inp<I_W_OUT_E>() + (size_t)i * D * D, D, D, (bf16*)(F.ws + WS_WOE) + (size_t)i * D * D, 32 * (r % 32), scr, 64 * (r / 32), 32 * (r % 32), F.lane); continue; } r -= I_O;
        if (r < I_IO) { tr_item(inp<I_W_IN_O>() + (size_t)i * D * OD_IN, D, OD_IN, (bf16*)(F.ws + WS_WINO) + (size_t)i * OD_INP * D, 32 * (r % 56), scr, 64 * (r / 56), 32 * (r % 56), F.lane); continue; } r -= I_IO;
        if (PROJ_FP8) tr_item8(inp<I_W_OUT_O>() + (size_t)i * D * D, D, D, (unsigned char*)(F.ws + WS_WOO) + (size_t)i * D * D, 32 * (r % 32), scr, 64 * (r / 32), 32 * (r % 32), F.lane, 64.f);
        else tr_item(inp<I_W_OUT_O>() + (size_t)i * D * D, D, D, (bf16*)(F.ws + WS_WOO) + (size_t)i * D * D, 32 * (r % 32), scr, 64 * (r / 32), 32 * (r % 32), F.lane);
    }
}
__device__ __forceinline__ void conv_ffn(Frame& F, int layer) {
    LAS float* scr = (LAS float*)(F.lds + F.wave * 16384);
    const int gw = F.bid * NWAVES + F.wave, NGW = F.G * NWAVES;
    const int i = layer >> 1; const bool odd = layer & 1; const int ne = odd ? NE : 1;
    const size_t lo_ = odd ? (size_t)i * NE * D * FF : (size_t)i * D * FF;
    constexpr int I13 = 16 * 112, I2 = 56 * 32, PER = 2 * I13 + I2;
    for (int it = gw; it < ne * PER; it += NGW) {
        const int e = it / PER; int r = it % PER;
        bf16* d13 = (bf16*)(F.ws + WS_W13) + (size_t)e * 2 * FF * D; bf16* d2 = (bf16*)(F.ws + WS_W2) + (size_t)e * D * FF;
        if (r < 2 * I13) { const int half = r / I13; r %= I13; const int n0 = 32 * (r % 112), k0 = 64 * (r / 112);
            const float* wsrc = (half ? (odd ? inp<I_E_W3>() : inp<I_F_W3>()) : (odd ? inp<I_E_W1>() : inp<I_F_W1>())) + lo_ + (size_t)e * D * FF;
            if (odd ? UP_FP8_MOE : UP_FP8_DENSE) tr_item8(wsrc, D, FF, (unsigned char*)(F.ws + WS_W13) + (size_t)e * 2 * FF * D, 256 * (n0 >> 7) + 128 * half + (n0 & 127), scr, k0, n0, F.lane, 32.f);
            else tr_item(wsrc, D, FF, d13, 256 * (n0 >> 7) + 128 * half + (n0 & 127), scr, k0, n0, F.lane);
            continue; }
        r -= 2 * I13;
        if (odd ? DOWN_FP8_MOE : DOWN_FP8_DENSE) tr_item8((odd ? inp<I_E_W2>() : inp<I_F_W2>()) + lo_ + (size_t)e * FF * D, FF, D, (unsigned char*)(F.ws + WS_W2) + (size_t)e * D * FF, 32 * (r % 32), scr, 64 * (r / 32), 32 * (r % 32), F.lane, 128.f);
        else tr_item((odd ? inp<I_E_W2>() : inp<I_F_W2>()) + lo_ + (size_t)e * FF * D, FF, D, d2, 32 * (r % 32), scr, 64 * (r / 32), 32 * (r % 32), F.lane);
    }
}
__device__ __forceinline__ void mod_phase(Frame& F) {
    LAS float* sc = (LAS float*)(F.lds);
    LAS float* part = (LAS float*)(F.lds + 16384);
    __syncthreads();
    { const float* cp_ = inp<I_C>(); for (int u = F.tid; u < NB * D; u += 512) { const float v = cp_[u]; sc[u] = v / (1.f + __expf(-v)); } }
    __syncthreads();
    const int kc = F.tid >> 6, col = F.tid & 63;
    for (int it = F.bid; it < 8 * 48; it += F.G) {
        const int ls = it / 48, cb = it % 48;
        const float* w = inp<I_ADA_W>() + (size_t)ls * D * 3 * D + cb * 64 + col;
        float a0 = 0.f, a1 = 0.f, a2 = 0.f, a3 = 0.f;
#pragma unroll 8
        for (int k = kc * 128; k < kc * 128 + 128; ++k) { const float wv = w[(size_t)k * 3 * D]; a0 += sc[k] * wv; a1 += sc[1024 + k] * wv; a2 += sc[2048 + k] * wv; a3 += sc[3072 + k] * wv; }
        part[(kc * 4 + 0) * 64 + col] = a0; part[(kc * 4 + 1) * 64 + col] = a1; part[(kc * 4 + 2) * 64 + col] = a2; part[(kc * 4 + 3) * 64 + col] = a3;
        __syncthreads();
        if (F.tid < 256) { const int b = F.tid >> 6; float s = 0.f;
#pragma unroll
            for (int k2 = 0; k2 < 8; ++k2) s += part[(k2 * 4 + b) * 64 + col];
            const int n3 = cb * 64 + col, j = n3 >> 10, n = n3 & 1023;
            s += inp<I_ADA_B>()[ls * 3 * D + n3] + (j ? 1.f : 0.f);
            ((float*)(F.ws + WS_MOD))[((ls * 3 + j) * NB + b) * D + n] = s; }
        __syncthreads();
    }
}
__device__ __forceinline__ const float* mod_ptr(Frame& F, int ls, int j, int b) { return (const float*)(F.ws + WS_MOD) + ((ls * 3 + j) * NB + b) * D; }

__device__ __forceinline__ void h0_phase(Frame& F) {
    const int row0 = F.bid * 128 + F.wave * 16, b = row0 >> 13;
    const float* sh = mod_ptr(F, 0, 0, b); const float* sc = mod_ptr(F, 0, 1, b);
    f32x4 shv[4], scv[4];
#pragma unroll
    for (int j = 0; j < 4; ++j) { shv[j] = *(const f32x4*)(sh + 4 * F.lane + 256 * j); scv[j] = *(const f32x4*)(sc + 4 * F.lane + 256 * j); }
    const float* xp_ = inp<I_X>();
    for (int i = 0; i < 16; ++i) { const int row = row0 + i;
        const f32x4* xr = (const f32x4*)(xp_ + (size_t)row * D) + F.lane; unsigned long long* o8 = (unsigned long long*)((bf16*)(F.ws + WS_H) + (size_t)row * D) + F.lane;
#pragma unroll
        for (int j = 0; j < 4; ++j) { const f32x4 v = xr[64 * j] * scv[j] + shv[j]; if (PROJ_FP8) ((unsigned*)(F.ws + WS_H + (size_t)row * D) + F.lane)[64 * j] = pk4_fp8(v.x, v.y, v.z, v.w); else o8[64 * j] = (unsigned long long)pk2(v.x, v.y) | ((unsigned long long)pk2(v.z, v.w) << 32); } }
}

template <int MODE>
__device__ __forceinline__ void ln_phase(Frame& F, int layer, int sub, bool last) {
    const int row0 = F.bid * 128 + F.wave * 16, b = row0 >> 13;
    const int ls = layer * 2 + sub, lsn = ls + 1;
    LAS float* wrt = (LAS float*)(F.lds);
    LAS int* cw = (LAS int*)(F.lds + 32768);
    if (MODE == 1) {
        __syncthreads();
        const float* wr = inp<I_ROUTER>() + (size_t)(layer >> 1) * D * NE;
        for (int u = F.tid; u < D * NE; u += 512) wrt[(u & 7) * 1024 + (u >> 3)] = wr[u];
        __syncthreads();
    }
    f32x4 gv[4], bv[4], shv[4], scv[4], gav[4];
    { const float* g = inp<I_LN_G>() + ls * D; const float* bb = inp<I_LN_B>() + ls * D;
#pragma unroll
      for (int j = 0; j < 4; ++j) { gv[j] = *(const f32x4*)(g + 4 * F.lane + 256 * j); bv[j] = *(const f32x4*)(bb + 4 * F.lane + 256 * j); } }
    if (!last) { const float* sh = mod_ptr(F, lsn, 0, b); const float* sc = mod_ptr(F, lsn, 1, b);
#pragma unroll
      for (int j = 0; j < 4; ++j) { shv[j] = *(const f32x4*)(sh + 4 * F.lane + 256 * j); scv[j] = *(const f32x4*)(sc + 4 * F.lane + 256 * j); } }
    if (MODE == 2) { const float* ga = mod_ptr(F, ls, 2, b);
#pragma unroll
      for (int j = 0; j < 4; ++j) gav[j] = *(const f32x4*)(ga + 4 * F.lane + 256 * j); }
    float dbgv = 0.f; if (PROBE_DBG && last) dbgv = __hip_atomic_load((float*)(F.ws + WS_DBG), __ATOMIC_RELAXED, __HIP_MEMORY_SCOPE_AGENT);
    unsigned long long cnt64 = 0ull;
    constexpr int RB = (MODE == 2) ? 2 : 4;
    for (int i0 = 0; i0 < 16; i0 += RB) {
      v2u xin[RB][4], rtv[RB], rgv[RB], ya[RB][4], yc[RB][4];
#pragma unroll
      for (int r = 0; r < RB; ++r) { const v2u* xp = (const v2u*)((const bf16*)(F.ws + WS_XH) + (size_t)(row0 + i0 + r) * D) + F.lane;
#pragma unroll
          for (int j = 0; j < 4; ++j) xin[r][j] = xp[64 * j];
          if (MODE == 2) { rtv[r] = *(const v2u*)(F.ws + WS_RT_S + (size_t)(row0 + i0 + r) * 8); rgv[r] = *(const v2u*)(F.ws + WS_RT_G + (size_t)(row0 + i0 + r) * 8); } }
      if (MODE == 2) {
#pragma unroll
          for (int r = 0; r < RB; ++r) { const unsigned s1 = rtv[r].x, s2 = rtv[r].y;
              const v2u* y1 = (const v2u*)((const bf16*)(F.ws + WS_XB) + (size_t)s1 * D) + F.lane; const v2u* y2 = (const v2u*)((const bf16*)(F.ws + WS_XB) + (size_t)s2 * D) + F.lane;
#pragma unroll
              for (int j = 0; j < 4; ++j) { ya[r][j] = y1[64 * j]; yc[r][j] = y2[64 * j]; } } }
#pragma unroll
      for (int r = 0; r < RB; ++r) { const int i = i0 + r; const int row = row0 + i;
        v2u* xr = (v2u*)((bf16*)(F.ws + WS_XH) + (size_t)row * D) + F.lane;
        f32x4 v[4]; float s = 0.f;
#pragma unroll
        for (int j = 0; j < 4; ++j) { const v2u a = xin[r][j]; v[j] = (f32x4){bflo(a.x), bfhi(a.x), bflo(a.y), bfhi(a.y)}; }
        if (MODE == 2) {
            const unsigned g1u = rgv[r].x, g2u = rgv[r].y; const float g1 = __uint_as_float(g1u), g2 = __uint_as_float(g2u);
#pragma unroll
            for (int j = 0; j < 4; ++j) { const v2u a = ya[r][j], c = yc[r][j];
                f32x4 ff; ff.x = g1 * bflo(a.x) + g2 * bflo(c.x); ff.y = g1 * bfhi(a.x) + g2 * bfhi(c.x); ff.z = g1 * bflo(a.y) + g2 * bflo(c.y); ff.w = g1 * bfhi(a.y) + g2 * bfhi(c.y);
                v[j] = v[j] * ALPHA + gav[j] * ff * AM_M; }
        }
#pragma unroll
        for (int j = 0; j < 4; ++j) s += (v[j].x + v[j].y) + (v[j].z + v[j].w);
        const float mean = wave_sum(s) * (1.f / D); float s2 = 0.f;
#pragma unroll
        for (int j = 0; j < 4; ++j) { v[j] = v[j] - mean; s2 += (v[j].x * v[j].x + v[j].y * v[j].y) + (v[j].z * v[j].z + v[j].w * v[j].w); }
        const float rstd = 1.f / sqrtf(wave_sum(s2) * (1.f / D) + LN_EPS);
#pragma unroll
        for (int j = 0; j < 4; ++j) { v[j] = v[j] * rstd * gv[j] + bv[j]; if (PROBE_DBG && last) v[j] = v[j] * (1.f + dbgv);
            if (last) ((f32x4*)((float*)inp<19>() + (size_t)row * D) + F.lane)[64 * j] = v[j];
            else { v2u w; w.x = pk2(v[j].x, v[j].y); w.y = pk2(v[j].z, v[j].w); xr[64 * j] = w; } }
        if (!last) {
            if ((sub == 0 && ((layer & 1) ? UP_FP8_MOE : UP_FP8_DENSE)) || (sub == 1 && (layer & 1) && PROJ_FP8)) {
                unsigned* o4 = (unsigned*)(F.ws + WS_H + (size_t)row * D) + F.lane;
#pragma unroll
                for (int j = 0; j < 4; ++j) { v[j] = v[j] * scv[j] + shv[j]; o4[64 * j] = pk4_fp8(v[j].x, v[j].y, v[j].z, v[j].w); }
            } else {
                unsigned long long* o8 = (unsigned long long*)((bf16*)(F.ws + WS_H) + (size_t)row * D) + F.lane;
#pragma unroll
                for (int j = 0; j < 4; ++j) { v[j] = v[j] * scv[j] + shv[j]; o8[64 * j] = (unsigned long long)pk2(v[j].x, v[j].y) | ((unsigned long long)pk2(v[j].z, v[j].w) << 32); }
            }
        }
        if (MODE == 1) {
            float lg[8];
#pragma unroll
            for (int e = 0; e < 8; ++e) { float a = 0.f;
#pragma unroll
                for (int j = 0; j < 4; ++j) { const f32x4 w = *(const LAS f32x4*)(wrt + e * 1024 + 256 * j + 4 * F.lane); a += (v[j].x * w.x + v[j].y * w.y) + (v[j].z * w.z + v[j].w * w.w); }
                lg[e] = a; __builtin_amdgcn_sched_barrier(0); }
            {
                const bool h5 = F.lane & 32, h4 = F.lane & 16, h3 = F.lane & 8;
                float a4[4], a2[2], a1;
#pragma unroll
                for (int k = 0; k < 4; ++k) { const float keep = h5 ? lg[4 + k] : lg[k], send = h5 ? lg[k] : lg[4 + k]; a4[k] = keep + __shfl_xor(send, 32); }
#pragma unroll
                for (int k = 0; k < 2; ++k) { const float keep = h4 ? a4[2 + k] : a4[k], send = h4 ? a4[k] : a4[2 + k]; a2[k] = keep + __shfl_xor(send, 16); }
                { const float keep = h3 ? a2[1] : a2[0], send = h3 ? a2[0] : a2[1]; a1 = keep + __shfl_xor(send, 8); }
                a1 += dpp_f<0xB1>(a1); a1 += dpp_f<0x4E>(a1); a1 += dpp_f<0x141>(a1);
#pragma unroll
                for (int e = 0; e < 8; ++e) lg[e] = __builtin_bit_cast(float, __builtin_amdgcn_readlane(__builtin_bit_cast(int, a1), ((e >> 2) & 1) * 32 + ((e >> 1) & 1) * 16 + (e & 1) * 8)); }
            int i1 = 0; float v1 = lg[0];
#pragma unroll
            for (int e = 1; e < 8; ++e) if (lg[e] > v1) { v1 = lg[e]; i1 = e; }
            int i2 = -1; float v2 = -3.0e38f;
#pragma unroll
            for (int e = 0; e < 8; ++e) if (e != i1 && lg[e] > v2) { v2 = lg[e]; i2 = e; }
            i1 = __builtin_amdgcn_readfirstlane(i1); i2 = __builtin_amdgcn_readfirstlane(i2);
            const float p2 = 1.f / (1.f + __expf(v1 - v2)), p1 = 1.f - p2;
            const unsigned r1 = (unsigned)(cnt64 >> (6 * i1)) & 63u; cnt64 += 1ull << (6 * i1);
            const unsigned r2 = (unsigned)(cnt64 >> (6 * i2)) & 63u; cnt64 += 1ull << (6 * i2);
            if (PROBE_DBG == 12 && layer == 1 && F.lane == 0) dbg_add(F, p1 * (1.f / (float)T));
            if (PROBE_DBG == 13 && layer == 1 && F.lane == 0) dbg_add(F, fabsf(v1) * (1.f / (float)T));
            if (F.lane == 0) { v2u re; re.x = (unsigned)i1 | (r1 << 8); re.y = (unsigned)i2 | (r2 << 8); v2u rg; rg.x = __builtin_bit_cast(unsigned, p1); rg.y = __builtin_bit_cast(unsigned, p2);
                *(v2u*)(F.ws + WS_RT_E + (size_t)row * 8) = re; *(v2u*)(F.ws + WS_RT_G + (size_t)row * 8) = rg; }
        }
      }
    }
    if (MODE == 1) {
        if (F.lane < 8) { const int cval = (int)((cnt64 >> (6 * F.lane)) & 63ull); cw[F.wave * 8 + F.lane] = cval; ((int*)(F.ws + WS_CNTW))[(F.bid * 8 + F.wave) * 8 + F.lane] = cval; }
        __syncthreads();
        if (F.tid < 8) { int s = 0;
#pragma unroll
            for (int w = 0; w < 8; ++w) s += cw[w * 8 + F.tid];
            ((int*)(F.ws + WS_CNTG))[F.bid * 8 + F.tid] = s; }
        __syncthreads();
    }
}
#define US ((const LAS int*)(F.lds + RING_BYTES + 512))
#define PRE ((const LAS int*)(F.lds + RING_BYTES + 576))
__device__ __forceinline__ void dense_units(Frame& F) {
    __syncthreads();
    if (F.tid < 9) ((LAS int*)(F.lds + RING_BYTES + 512))[F.tid] = F.tid ? T / 256 : 0;
    __syncthreads();
}
__device__ __forceinline__ void moe_units(Frame& F) {
    LAS int* acc = (LAS int*)(F.lds + RING_BYTES + 640);
    __syncthreads();
    if (F.tid < 16) acc[F.tid] = 0;
    __syncthreads();
    if (F.tid < 256) { const int* cg = (const int*)(F.ws + WS_CNTG) + F.tid * 8;
#pragma unroll
        for (int e = 0; e < 8; ++e) { const int v = cg[e]; __hip_atomic_fetch_add(acc + e, v, __ATOMIC_RELAXED, __HIP_MEMORY_SCOPE_WORKGROUP); if (F.tid < F.bid) __hip_atomic_fetch_add(acc + 8 + e, v, __ATOMIC_RELAXED, __HIP_MEMORY_SCOPE_WORKGROUP); } }
    __syncthreads();
    if (F.tid == 0) { int u0 = 0; LAS int* us = (LAS int*)(F.lds + RING_BYTES + 512); LAS int* pre = (LAS int*)(F.lds + RING_BYTES + 576);
        for (int e = 0; e < 8; ++e) { us[e] = u0; u0 += (acc[e] + 255) >> 8; pre[e] = acc[8 + e]; }
        us[8] = u0; }
    __syncthreads();
}
__device__ __forceinline__ void gather_phase(Frame& F, int layer) {
    moe_units(F);
    if (PROBE_DBG == 4 && layer == 1 && F.bid == 0 && F.tid == 0) dbg_add(F, (float)(US[8] - 256) * 0.125f);
    if (PROBE_DBG == 5 && layer == 1 && F.bid == 255 && F.tid == 0) dbg_add(F, (float)PRE[0] * (1.f / 8192.f));
    int wp[8];
#pragma unroll
    for (int e = 0; e < 8; ++e) { int s = 0; for (int w = 0; w < F.wave; ++w) s += ((const int*)(F.ws + WS_CNTW))[(F.bid * 8 + w) * 8 + e]; wp[e] = US[e] * 256 + PRE[e] + s; }
    const int row0 = F.bid * 128 + F.wave * 16;
    for (int i = 0; i < 16; ++i) { const int row = row0 + i;
        v2u rt = *(const v2u*)(F.ws + WS_RT_E + (size_t)row * 8);
        const int e1 = rt.x & 255, r1 = rt.x >> 8, e2 = rt.y & 255, r2 = rt.y >> 8;
        int b1 = 0, b2 = 0;
#pragma unroll
        for (int e = 0; e < 8; ++e) { b1 = (e == e1) ? wp[e] : b1; b2 = (e == e2) ? wp[e] : b2; }
        const int s1 = b1 + r1, s2 = b2 + r2;
        if (UP_FP8_MOE) {
            const v4u a = ((const v4u*)(F.ws + WS_H + (size_t)row * D))[F.lane];
            ((v4u*)(F.ws + WS_XB + (size_t)s1 * D))[F.lane] = a; ((v4u*)(F.ws + WS_XB + (size_t)s2 * D))[F.lane] = a;
        } else {
        const v4u* src = (const v4u*)((const bf16*)(F.ws + WS_H) + (size_t)row * D) + F.lane;
        v4u* d1 = (v4u*)((bf16*)(F.ws + WS_XB) + (size_t)s1 * D) + F.lane; v4u* d2 = (v4u*)((bf16*)(F.ws + WS_XB) + (size_t)s2 * D) + F.lane;
        const v4u a = src[0], c = src[64]; d1[0] = a; d1[64] = c; d2[0] = a; d2[64] = c;
        }
        if (PROBE_DBG == 6 && layer == 1 && F.lane == 0) dbg_add(F, (float)s1 * (1.f / ((float)T * 32768.f)));
        if (F.lane == 0) { v2u rs; rs.x = (unsigned)s1; rs.y = (unsigned)s2; *(v2u*)(F.ws + WS_RT_S + (size_t)row * 8) = rs; }
    }
}

__device__ __forceinline__ void combine_item(Frame& F, int row, int c8) { const int h = c8 >> 3;
        const float* lse = (const float*)(F.ws + WS_LSE);
        const float l0 = lse[((size_t)0 * T + row) * 8 + h], l1 = lse[((size_t)1 * T + row) * 8 + h], l2 = lse[((size_t)2 * T + row) * 8 + h];
        const float mx = fmaxf(l0, fmaxf(l1, l2)); float w0 = __builtin_amdgcn_exp2f(l0 - mx), w1 = __builtin_amdgcn_exp2f(l1 - mx), w2 = __builtin_amdgcn_exp2f(l2 - mx);
        const float inv = 1.f / (w0 + w1 + w2); w0 *= inv; w1 *= inv; w2 *= inv;
        const bf16* P = (const bf16*)(F.ws + WS_PART);
        const v4u a = *(const v4u*)(P + ((size_t)0 * T + row) * 512 + c8 * 8), c = *(const v4u*)(P + ((size_t)1 * T + row) * 512 + c8 * 8), d = *(const v4u*)(P + ((size_t)2 * T + row) * 512 + c8 * 8);
        if (PROJ_FP8) { v2u o8;
            o8.x = pk4_fp8(w0 * bflo(a.x) + w1 * bflo(c.x) + w2 * bflo(d.x), w0 * bfhi(a.x) + w1 * bfhi(c.x) + w2 * bfhi(d.x), w0 * bflo(a.y) + w1 * bflo(c.y) + w2 * bflo(d.y), w0 * bfhi(a.y) + w1 * bfhi(c.y) + w2 * bfhi(d.y));
            o8.y = pk4_fp8(w0 * bflo(a.z) + w1 * bflo(c.z) + w2 * bflo(d.z), w0 * bfhi(a.z) + w1 * bfhi(c.z) + w2 * bfhi(d.z), w0 * bflo(a.w) + w1 * bflo(c.w) + w2 * bflo(d.w), w0 * bfhi(a.w) + w1 * bfhi(c.w) + w2 * bfhi(d.w));
            *(v2u*)((unsigned char*)(F.ws + WS_O) + (size_t)row * D + c8 * 8) = o8; return; }
        v4u o;
        o.x = pk2(w0 * bflo(a.x) + w1 * bflo(c.x) + w2 * bflo(d.x), w0 * bfhi(a.x) + w1 * bfhi(c.x) + w2 * bfhi(d.x));
        o.y = pk2(w0 * bflo(a.y) + w1 * bflo(c.y) + w2 * bflo(d.y), w0 * bfhi(a.y) + w1 * bfhi(c.y) + w2 * bfhi(d.y));
        o.z = pk2(w0 * bflo(a.z) + w1 * bflo(c.z) + w2 * bflo(d.z), w0 * bfhi(a.z) + w1 * bfhi(c.z) + w2 * bfhi(d.z));
        o.w = pk2(w0 * bflo(a.w) + w1 * bflo(c.w) + w2 * bflo(d.w), w0 * bfhi(a.w) + w1 * bfhi(c.w) + w2 * bfhi(d.w));
        *(v4u*)((bf16*)(F.ws + WS_O) + (size_t)row * D + c8 * 8) = o; }
__device__ __forceinline__ void band_phase(Frame& F, int li) {
    LAS float* btab = (LAS float*)(F.lds);
    LAS unsigned char* vbuf = F.lds + 32768 + F.wave * 4096;
    __syncthreads();
    const float* relp_ = inp<I_REL>();
    for (int u = F.tid; u < 4 * 8 * 129; u += 512) { const int cfg = u / (8 * 129), r = u % (8 * 129), h = r / 129, dist = r % 129;
        const int dil = cfg == 1 ? 4 : (cfg == 2 ? 16 : 1);
        btab[(cfg * 8 + h) * 132 + dist] = relp_[t5_bucket(dil * dist) * 16 + (cfg == 3 ? 8 + h : h)] * LOG2E; }
    __syncthreads();
    const bf16* QKV = (const bf16*)(F.ws + WS_QKV);
    const int lane = F.lane, n = lane & 31, hi = lane >> 5;
    const int gw = F.bid * NWAVES + F.wave, NGW = F.G * NWAVES;
    for (int wu = F.bid; wu < NB * 16 * 8; wu += F.G) {
      const int hq = wu & 7, blk = (wu >> 3) & 15, b = wu >> 7;
      for (int qi_ = F.wave; qi_ < 64; qi_ += NWAVES) {
        const int cfg = qi_ >> 4, sub = qi_ & 15;
        const int dsh = cfg == 1 ? 2 : (cfg == 2 ? 4 : 0), dil = 1 << dsh;
        const int r = cfg == 1 ? (sub >> 2) : (cfg == 2 ? sub : 0), tile = cfg == 1 ? (4 * blk + (sub & 3)) : (cfg == 2 ? blk : 16 * blk + sub), i0 = tile * 32;
        const int qoff = cfg == 3 ? 1536 : 0, koff = cfg == 3 ? 2048 : 512, voff = cfg == 3 ? 2176 : 1024, hk = cfg == 3 ? (hq >> 2) : hq, W = cfg == 3 ? 127 : 128;
        const size_t rowbase = (size_t)b * SEQ + r;
        const LAS float* bt = btab + (cfg * 8 + hq) * 132;
        bf16x8 qf[4];
        { const bf16* qrow = QKV + (rowbase + (size_t)(i0 + n) * dil) * EV_IN + qoff + hq * 64 + 8 * hi;
#pragma unroll
          for (int s = 0; s < 4; ++s) qf[s] = *(const bf16x8*)(qrow + 16 * s); }
        float m = NEGF, l = 0.f; f32x16 o0, o1;
#pragma unroll
        for (int i = 0; i < 16; ++i) { o0[i] = 0.f; o1[i] = 0.f; }
        const int jlo = (4 - tile) > 0 ? (4 - tile) : 0;
        bf16x8 kf[4], kn[4]; v4u vv[4], vn[4];
        { const int kj0 = i0;
          const bf16* krow = QKV + (rowbase + (size_t)(kj0 + n) * dil) * EV_IN + koff + hk * 64 + 8 * hi;
#pragma unroll
          for (int s = 0; s < 4; ++s) kf[s] = *(const bf16x8*)(krow + 16 * s);
#pragma unroll
          for (int i = 0; i < 4; ++i) { const int c = lane + 64 * i, key = c >> 3, ch = c & 7;
              vv[i] = *(const v4u*)(QKV + (rowbase + (size_t)(kj0 + key) * dil) * EV_IN + voff + hk * 64 + ch * 8); } }
        for (int j = 4; j >= jlo; --j) {
            if (j > jlo) { const int kj1 = i0 - 128 + 32 * (j - 1);
                const bf16* krow = QKV + (rowbase + (size_t)(kj1 + n) * dil) * EV_IN + koff + hk * 64 + 8 * hi;
#pragma unroll
                for (int s = 0; s < 4; ++s) kn[s] = *(const bf16x8*)(krow + 16 * s);
#pragma unroll
                for (int i = 0; i < 4; ++i) { const int c = lane + 64 * i, key = c >> 3, ch = c & 7;
                    vn[i] = *(const v4u*)(QKV + (rowbase + (size_t)(kj1 + key) * dil) * EV_IN + voff + hk * 64 + ch * 8); } }
            CBAR();
#pragma unroll
            for (int i = 0; i < 4; ++i) { const int c = lane + 64 * i, key = c >> 3, ch = c & 7;
                *(LAS v4u*)(vbuf + (ch >> 2) * 2048 + key * 64 + (ch & 3) * 16) = vv[i]; }
            f32x16 s;
#pragma unroll
            for (int i = 0; i < 16; ++i) s[i] = 0.f;
#pragma unroll
            for (int k = 0; k < 4; ++k) s = __builtin_amdgcn_mfma_f32_32x32x16_bf16(kf[k], qf[k], s, 0, 0, 0);
            const int dbase = 128 - 32 * j + n - 4 * hi;
            float mx = NEGF;
            if (j == 0 || j == 4) {
#pragma unroll
                for (int i = 0; i < 16; ++i) { const int dist = dbase - (i & 3) - 8 * (i >> 2); const bool ok = dist >= 0 && dist <= W;
                    const int di = dist < 0 ? 0 : (dist > 128 ? 128 : dist);
                    const float xv = s[i] * C2 + bt[di]; s[i] = ok ? xv : NEGF; mx = fmaxf(mx, s[i]); }
            } else {
                const LAS float* btd = bt + dbase;
#pragma unroll
                for (int i = 0; i < 16; ++i) { s[i] = s[i] * C2 + btd[-((i & 3) + 8 * (i >> 2))]; mx = fmaxf(mx, s[i]); }
            }
            mx = max32(mx);
            const float mnew = fmaxf(m, mx), alpha = __builtin_amdgcn_exp2f(m - mnew);
            float rs = 0.f;
#pragma unroll
            for (int i = 0; i < 16; ++i) { s[i] = __builtin_amdgcn_exp2f(s[i] - mnew); rs += s[i]; }
            rs = sum32(rs);
            l = l * alpha + rs; m = mnew;
#pragma unroll
            for (int i = 0; i < 16; ++i) { o0[i] *= alpha; o1[i] *= alpha; }
            bf16x8 pb[2];
#pragma unroll
            for (int ks = 0; ks < 2; ++ks) { v4u w; w.x = pk2(s[8 * ks + 0], s[8 * ks + 1]); w.y = pk2(s[8 * ks + 2], s[8 * ks + 3]); w.z = pk2(s[8 * ks + 4], s[8 * ks + 5]); w.w = pk2(s[8 * ks + 6], s[8 * ks + 7]);
                pb[ks] = __builtin_bit_cast(bf16x8, w); }
            CBAR();
            const int q4 = (lane & 15) >> 2, p4 = lane & 3, blk = (lane >> 4) & 1;
            const LAS unsigned char* vb = vbuf + (4 * hi + q4) * 64 + (16 * blk + 4 * p4) * 2;
#pragma unroll
            for (int dt = 0; dt < 2; ++dt)
#pragma unroll
                for (int ks = 0; ks < 2; ++ks) { const s16x4 lo = vtr(vb + dt * 2048 + (16 * ks) * 64), hh = vtr(vb + dt * 2048 + (16 * ks + 8) * 64);
                    const bf16x8 va = (bf16x8){lo[0], lo[1], lo[2], lo[3], hh[0], hh[1], hh[2], hh[3]};
                    if (dt == 0) o0 = __builtin_amdgcn_mfma_f32_32x32x16_bf16(va, pb[ks], o0, 0, 0, 0); else o1 = __builtin_amdgcn_mfma_f32_32x32x16_bf16(va, pb[ks], o1, 0, 0, 0); }
            CBAR();
            if (j > jlo) {
#pragma unroll
                for (int i = 0; i < 4; ++i) { kf[i] = kn[i]; vv[i] = vn[i]; } }
        }
        const size_t orow = rowbase + (size_t)(i0 + n) * dil;
        if (cfg == 3) l += __builtin_amdgcn_exp2f(inp<I_SINKS>()[li * 8 + hq] * LOG2E - m);
        const float inv = 1.f / l;
        bf16* op = cfg == 3 ? (bf16*)(F.ws + WS_O) + orow * D + 512 + hq * 64 : (bf16*)(F.ws + WS_PART) + ((size_t)cfg * T + orow) * 512 + hq * 64;
        if (PROJ_FP8 && cfg == 3) { unsigned char* o8p = (unsigned char*)(F.ws + WS_O) + orow * D + 512 + hq * 64;
#pragma unroll
            for (int g = 0; g < 4; ++g) { *(unsigned*)(o8p + 8 * g + 4 * hi) = pk4_fp8(o0[4 * g] * inv, o0[4 * g + 1] * inv, o0[4 * g + 2] * inv, o0[4 * g + 3] * inv);
                *(unsigned*)(o8p + 32 + 8 * g + 4 * hi) = pk4_fp8(o1[4 * g] * inv, o1[4 * g + 1] * inv, o1[4 * g + 2] * inv, o1[4 * g + 3] * inv); } }
        else
#pragma unroll
        for (int g = 0; g < 4; ++g) { v2u w0, w1; w0.x = pk2(o0[4 * g] * inv, o0[4 * g + 1] * inv); w0.y = pk2(o0[4 * g + 2] * inv, o0[4 * g + 3] * inv);
            w1.x = pk2(o1[4 * g] * inv, o1[4 * g + 1] * inv); w1.y = pk2(o1[4 * g + 2] * inv, o1[4 * g + 3] * inv);
            *(v2u*)(op + 8 * g + 4 * hi) = w0; *(v2u*)(op + 32 + 8 * g + 4 * hi) = w1; }
        if (cfg < 3 && hi == 0) ((float*)(F.ws + WS_LSE))[((size_t)cfg * T + orow) * 8 + hq] = m + __builtin_amdgcn_logf(l);
      }
      VM_WAIT(); __syncthreads(); __builtin_amdgcn_fence(__ATOMIC_ACQUIRE, "agent"); VM_WAIT();
      for (int ci = F.tid; ci < 512 * 8; ci += 512) { const int row = b * SEQ + blk * 512 + (ci >> 3), c8 = hq * 8 + (ci & 7); combine_item(F, row, c8); }
    }
}
__device__ __forceinline__ void find_bin(const LAS unsigned* hist, int K, int lane, int& bout, int& nabout) {
    const v4u c = *(const LAS v4u*)(hist + 4 * lane);
    const int s = (int)(c.x + c.y + c.z + c.w); int suf = s;
#pragma unroll
    for (int off = 1; off < 64; off <<= 1) { const int v = __shfl_down(suf, off); if (lane + off < 64) suf += v; }
    const unsigned long long mask = __ballot(suf >= K);
    const int Ls = mask ? 63 - __builtin_clzll(mask) : 0;
    int above = suf - s, bb;
    if (above + (int)c.w >= K) bb = 3; else { above += (int)c.w; if (above + (int)c.z >= K) bb = 2; else { above += (int)c.z; if (above + (int)c.y >= K) bb = 1; else { above += (int)c.y; bb = 0; } } }
    bout = __shfl(4 * lane + bb, Ls); nabout = __shfl(above, Ls);
}
__device__ __forceinline__ unsigned f16key(float v) { const _Float16 h = (_Float16)v; const unsigned short b = __builtin_bit_cast(unsigned short, h); return (b & 0x8000u) ? (unsigned)(~b & 0xffffu) : (unsigned)(b | 0x8000u); }
#define PINV(x) asm volatile("" : "+v"(x))
__device__ __forceinline__ void idx_scores(const bf16x8 (&kf)[4], const LAS unsigned char* QF, const float (&wq)[8], int lane, f32x16& sc) {
#pragma unroll
    for (int i = 0; i < 16; ++i) sc[i] = 0.f;
    bf16x8 qfr[2][4];
#pragma unroll
    for (int s = 0; s < 4; ++s) qfr[0][s] = *(const LAS bf16x8*)(QF + ((0 * 4 + s) * 64 + lane) * 16);
    f32x16 dprev;
#pragma unroll
    for (int hh = 0; hh < 9; ++hh) { f32x16 d;
        if (hh < 8) {
#pragma unroll
            for (int s = 0; s < 4; ++s) qfr[(hh + 1) & 1][s] = *(const LAS bf16x8*)(QF + (((hh + 1) * 4 + s) * 64 + lane) * 16);
        }
#pragma unroll
        for (int i = 0; i < 16; ++i) d[i] = 0.f;
#pragma unroll
        for (int s = 0; s < 4; ++s) { d = __builtin_amdgcn_mfma_f32_32x32x16_bf16(kf[s], qfr[hh & 1][s], d, 0, 0, 0); PINV(d);
            if (hh > 0) {
#pragma unroll
                for (int i = 4 * s; i < 4 * s + 4; ++i) { sc[i] = __builtin_fmaf(__builtin_fabsf(dprev[i]), wq[hh - 1], sc[i]); PINV(sc[i]); }
            } }
        dprev = d; }
#pragma unroll
    for (int i = 0; i < 16; ++i) sc[i] += dprev[i];
}
__device__ __forceinline__ void indexer_phase(Frame& F) {
    LAS unsigned char* QF = F.lds;
    LAS unsigned* H1 = (LAS unsigned*)(F.lds + 36864);
    LAS unsigned* H2 = (LAS unsigned*)(F.lds + 36864 + 33280);
    LAS int* QI = (LAS int*)(F.lds + 36864 + 2 * 33280);
    const bf16* QKV = (const bf16*)(F.ws + WS_QKV);
    unsigned short* SCR = (unsigned short*)(F.ws + WS_SCR) + (size_t)F.bid * (256 * 1024);
    const int lane = F.lane, n = lane & 31, hi = lane >> 5;
    for (int ui = 0; ui < 4; ++ui) {
        const int c = F.bid; const int uu = ui == 0 ? c : (ui == 1 ? 511 - c : (ui == 2 ? 512 + c : 1023 - c));
        if (F.G != 256) break;
        const int b = uu >> 8, qb = uu & 255, T0 = qb * 32; const size_t base = (size_t)b * SEQ;
        __syncthreads();
        for (int u = F.tid; u < 2 * 32 * 260; u += 512) H1[u] = 0u;
        for (int cc = F.tid; cc < 9 * 256; cc += 512) { const int hh = cc >> 8, s = (cc >> 6) & 3, ln = cc & 63, nn = ln & 31, h2 = ln >> 5;
            const bf16* qrow = QKV + (base + T0 + nn) * OD_INP;
            v4u o;
            if (hh < 8) o = *(const v4u*)(qrow + 1152 + hh * 64 + 16 * s + 8 * h2);
            else { float a[8];
#pragma unroll
                for (int e = 0; e < 8; ++e) a[e] = 0.f;
#pragma unroll
                for (int g = 0; g < 8; ++g) { const float w = 0.5f * WIS * bf2f(qrow[1728 + g]); const v4u q = *(const v4u*)(qrow + 1152 + g * 64 + 16 * s + 8 * h2);
                    a[0] += w * bflo(q.x); a[1] += w * bfhi(q.x); a[2] += w * bflo(q.y); a[3] += w * bfhi(q.y); a[4] += w * bflo(q.z); a[5] += w * bfhi(q.z); a[6] += w * bflo(q.w); a[7] += w * bfhi(q.w); }
                o.x = pk2(a[0], a[1]); o.y = pk2(a[2], a[3]); o.z = pk2(a[4], a[5]); o.w = pk2(a[6], a[7]); }
            *(LAS v4u*)(QF + cc * 16) = o; }
        float wq[8];
        { const bf16* qrow = QKV + (base + T0 + n) * OD_INP + 1728;
#pragma unroll
          for (int g = 0; g < 8; ++g) wq[g] = 0.5f * WIS * bf2f(qrow[g]); }
        __syncthreads();
        { bf16x8 kf[4], kn[4];
          const bf16* krow0 = QKV + (base + n) * OD_INP + 1664 + 8 * hi;
          if (F.wave <= qb) {
#pragma unroll
              for (int s = 0; s < 4; ++s) kf[s] = *(const bf16x8*)(krow0 + (size_t)(32 * F.wave) * OD_INP + 16 * s); }
          for (int j = F.wave; j <= qb; j += 8) {
            const bool more = j + 8 <= qb;
            if (more) {
#pragma unroll
                for (int s = 0; s < 4; ++s) kn[s] = *(const bf16x8*)(krow0 + (size_t)(32 * (j + 8)) * OD_INP + 16 * s); }
            f32x16 sc; idx_scores(kf, QF, wq, lane, sc);
            unsigned k16[16];
#pragma unroll
            for (int i = 0; i < 16; ++i) { const int key = 32 * j + crow(i, hi); const bool ok = key <= T0 + n; k16[i] = ok ? f16key(sc[i]) : 0u;
                if (ok) __hip_atomic_fetch_add(H1 + n * 260 + (k16[i] >> 8), 1u, __ATOMIC_RELAXED, __HIP_MEMORY_SCOPE_WORKGROUP); }
            unsigned short* sp = SCR + (size_t)j * 1024 + n * 32 + 4 * hi;
#pragma unroll
            for (int g = 0; g < 4; ++g) { v2u w; w.x = k16[4 * g] | (k16[4 * g + 1] << 16); w.y = k16[4 * g + 2] | (k16[4 * g + 3] << 16); *(v2u*)(sp + 8 * g) = w; }
            if (more) {
#pragma unroll
                for (int s = 0; s < 4; ++s) kf[s] = kn[s]; }
          } }
        VM_WAIT();
        __syncthreads();
        __builtin_amdgcn_fence(__ATOMIC_ACQUIRE, "agent");
        VM_WAIT();
        for (int qq = 0; qq < 4; ++qq) { const int nq = F.wave * 4 + qq, tpos = T0 + nq, K = tpos + 1 < 256 ? tpos + 1 : 256;
            int b1, nab; find_bin(H1 + nq * 260, K, lane, b1, nab);
            if (lane == 0) { QI[nq] = b1; QI[32 + nq] = nab; } }
        __syncthreads();
        const int qn = lane >> 1, hf = lane & 1;
        { const int b1 = QI[qn];
          for (int j0 = F.wave; j0 <= qb; j0 += 32) { v4u w[4][2];
#pragma unroll
            for (int u = 0; u < 4; ++u) { const int j = j0 + 8 * u; const v4u* rp = (const v4u*)(SCR + (size_t)(j <= qb ? j : j0) * 1024 + qn * 32 + hf * 16); w[u][0] = rp[0]; w[u][1] = rp[1]; }
#pragma unroll
            for (int u = 0; u < 4; ++u) { if (j0 + 8 * u <= qb) {
#pragma unroll
                for (int q4 = 0; q4 < 2; ++q4)
#pragma unroll
                    for (int e = 0; e < 4; ++e) { const unsigned lo = w[u][q4][e] & 0xffffu, hh = w[u][q4][e] >> 16;
                        if ((int)(lo >> 8) == b1) __hip_atomic_fetch_add(H2 + qn * 260 + (lo & 255u), 1u, __ATOMIC_RELAXED, __HIP_MEMORY_SCOPE_WORKGROUP);
                        if ((int)(hh >> 8) == b1) __hip_atomic_fetch_add(H2 + qn * 260 + (hh & 255u), 1u, __ATOMIC_RELAXED, __HIP_MEMORY_SCOPE_WORKGROUP); } } } } }
        __syncthreads();
        for (int qq = 0; qq < 4; ++qq) { const int nq = F.wave * 4 + qq, tpos = T0 + nq, K = tpos + 1 < 256 ? tpos + 1 : 256;
            const int b1 = QI[nq], nab = QI[32 + nq];
            int b2, nab2; find_bin(H2 + nq * 260, K - nab, lane, b2, nab2);
            if (lane == 0) { QI[64 + nq] = (b1 << 8) | b2; QI[96 + nq] = K - nab - nab2; }
            unsigned short* ip = (unsigned short*)(F.ws + WS_IDX) + (base + tpos) * 256;
            if (K < 256) { for (int p = K + lane; p < 256; p += 64) ip[p] = 0; } }
        __syncthreads();
        { const unsigned thr = (unsigned)QI[64 + qn];
          LAS unsigned char* CNT = (LAS unsigned char*)H1;
          for (int j0 = F.wave; j0 <= qb; j0 += 32) { v4u w[4][2];
#pragma unroll
            for (int u = 0; u < 4; ++u) { const int j = j0 + 8 * u; const v4u* rp = (const v4u*)(SCR + (size_t)(j <= qb ? j : j0) * 1024 + qn * 32 + hf * 16); w[u][0] = rp[0]; w[u][1] = rp[1]; }
#pragma unroll
            for (int u = 0; u < 4; ++u) { const int j = j0 + 8 * u; if (j <= qb) { int cgt = 0, ceq = 0;
#pragma unroll
                for (int q4 = 0; q4 < 2; ++q4)
#pragma unroll
                    for (int e = 0; e < 4; ++e) { const unsigned lo = w[u][q4][e] & 0xffffu, hh = w[u][q4][e] >> 16; cgt += (lo > thr) + (hh > thr); ceq += (lo == thr) + (hh == thr); }
                *(LAS unsigned short*)(CNT + (qn * 256 + j) * 4 + hf * 2) = (unsigned short)(cgt | (ceq << 8)); } } } }
        __syncthreads();
        for (int qq = 0; qq < 4; ++qq) { const int nq = F.wave * 4 + qq;
            const v4u cw = *(const LAS v4u*)(H1 + nq * 256 + 4 * lane);
            int g[4], e[4], sg = 0, se = 0;
#pragma unroll
            for (int k = 0; k < 4; ++k) { const unsigned w = (4 * lane + k <= qb) ? cw[k] : 0u; g[k] = (int)((w & 0xffu) + ((w >> 16) & 0xffu)); e[k] = (int)(((w >> 8) & 0xffu) + (w >> 24)); sg += g[k]; se += e[k]; }
            int pg = sg, pe = se;
#pragma unroll
            for (int off = 1; off < 64; off <<= 1) { const int vg = __shfl_up(pg, off), ve = __shfl_up(pe, off); if (lane >= off) { pg += vg; pe += ve; } }
            pg -= sg; pe -= se;
            v4u o;
#pragma unroll
            for (int k = 0; k < 4; ++k) { o[k] = (unsigned)pg | ((unsigned)pe << 16); pg += g[k]; pe += e[k]; }
            *(LAS v4u*)(H2 + nq * 256 + 4 * lane) = o; }
        __syncthreads();
        { const unsigned thr = (unsigned)QI[64 + qn]; const int mt = QI[96 + qn];
          const LAS unsigned char* CNT = (const LAS unsigned char*)H1;
          unsigned short* ip = (unsigned short*)(F.ws + WS_IDX) + (base + T0 + qn) * 256;
          for (int j0 = F.wave; j0 <= qb; j0 += 32) { v4u w[4][2];
#pragma unroll
            for (int u = 0; u < 4; ++u) { const int j = j0 + 8 * u;
                const bool need = j <= qb && *(const LAS unsigned short*)(CNT + (qn * 256 + j) * 4 + hf * 2) != 0;
                const v4u* rp = (const v4u*)(SCR + (need ? (size_t)j * 1024 + qn * 32 + hf * 16 : (size_t)0)); w[u][0] = rp[0]; w[u][1] = rp[1]; }
#pragma unroll
            for (int u = 0; u < 4; ++u) { const int j = j0 + 8 * u; if (j <= qb) {
            const unsigned of = H2[qn * 256 + j]; const unsigned c0 = *(const LAS unsigned short*)(CNT + (qn * 256 + j) * 4), cme = *(const LAS unsigned short*)(CNT + (qn * 256 + j) * 4 + hf * 2);
            int ng = (int)(of & 0xffffu) + (hf ? (int)(c0 & 0xffu) : 0), ne = (int)(of >> 16) + (hf ? (int)(c0 >> 8) : 0);
            if (cme) {
#pragma unroll
            for (int q4 = 0; q4 < 2; ++q4)
#pragma unroll
                for (int e = 0; e < 4; ++e)
#pragma unroll
                    for (int h2 = 0; h2 < 2; ++h2) { const unsigned kv = h2 ? (w[u][q4][e] >> 16) : (w[u][q4][e] & 0xffffu); const int key = j * 32 + hf * 16 + q4 * 8 + e * 2 + h2;
                        if (kv > thr) { ip[ng + (ne < mt ? ne : mt)] = (unsigned short)key; ++ng; }
                        else if (kv == thr) { if (ne < mt) ip[ng + ne] = (unsigned short)key; ++ne; } } } } } } }
    }
}
__device__ __forceinline__ void sparse_phase(Frame& F) {
    LAS unsigned char* btb = F.lds;
    LAS float* rtab = (LAS float*)(F.lds + 8192);
    LAS unsigned* tabs = (LAS unsigned*)(F.lds + 8192 + 2304 + F.wave * 4096);
    LAS unsigned char* vbuf = F.lds + 8192 + 2304 + 8 * 4096 + F.wave * 8192;
    __syncthreads();
    for (int u = F.tid; u < 8192; u += 512) btb[u] = (unsigned char)t5_bucket(u);
    { const int u = F.tid; rtab[u] = inp<I_REL>()[u] * LOG2E; if (u < 16) rtab[512 + u] = NEGF; }
    __syncthreads();
    const bf16* QKV = (const bf16*)(F.ws + WS_QKV);
    const int lane = F.lane, n = lane & 15, kb = lane >> 4;
    const int gw = F.bid * NWAVES + F.wave, NGW = F.G * NWAVES;
    const int q4 = (lane & 15) >> 2, p4 = lane & 3;
    int cur = 0;
    bf16x8 qf[2], kf[4][2], kn[4][2]; v4u vv[8], vn[8];
#define SP_TABS(BUF, IDX4, TPOS, NV) do { const v2u i4_ = (IDX4); v4u ro_, bo_; \
        _Pragma("unroll") for (int e_ = 0; e_ < 4; ++e_) { const unsigned iw_ = (e_ < 2) ? i4_.x : i4_.y; const int ki_ = (e_ & 1) ? (int)(iw_ >> 16) : (int)(iw_ & 0xffffu); \
            int dist_ = (TPOS) - ki_; dist_ = dist_ < 0 ? 0 : dist_; ro_[e_] = (unsigned)ki_ * (unsigned)(OD_INP * 2); bo_[e_] = (4 * lane + e_ < (NV)) ? (unsigned)btb[dist_] * 64u : 2048u; } \
        *(LAS v4u*)(tabs + (BUF) * 512 + 4 * lane) = ro_; *(LAS v4u*)(tabs + (BUF) * 512 + 256 + 4 * lane) = bo_; } while (0)
#define SP_GATHER(KD, VD, BUF, BASE, CK) do { const char* qb_ = (const char*)(QKV + (BASE) * OD_INP); \
        _Pragma("unroll") for (int jt = 0; jt < 4; ++jt) { const unsigned ro_ = tabs[(BUF) * 512 + 64 * (CK) + 16 * jt + n]; \
            const bf16* krow = (const bf16*)(qb_ + ro_) + 1024 + 8 * kb; KD[jt][0] = *(const bf16x8*)(krow); KD[jt][1] = *(const bf16x8*)(krow + 32); } \
        _Pragma("unroll") for (int i = 0; i < 8; ++i) { const int c = lane + 64 * i, key = c >> 3, ch = c & 7; const unsigned ro_ = tabs[(BUF) * 512 + 64 * (CK) + key]; \
            VD[i] = *(const v4u*)((const bf16*)(qb_ + ro_) + 1088 + ch * 8); } } while (0)
    if (gw < T) { const int tp0 = gw & 8191, nv0 = tp0 + 1 < 256 ? tp0 + 1 : 256;
        SP_TABS(0, *(const v2u*)((const unsigned short*)(F.ws + WS_IDX) + (size_t)gw * 256 + 4 * lane), tp0, nv0);
        { const bf16* qrow = QKV + (size_t)gw * OD_INP + n * 64 + 8 * kb; qf[0] = *(const bf16x8*)(qrow); qf[1] = *(const bf16x8*)(qrow + 32); }
        LDS_WAIT(); CBAR();
        SP_GATHER(kf, vv, 0, (size_t)(gw >> 13) * SEQ, 0);
    }
    for (int t = gw; t < T; t += NGW) {
        const int tpos = t & 8191, nv = tpos + 1 < 256 ? tpos + 1 : 256;
        const int tn = t + NGW; const bool hasn = tn < T;
        v2u inext = (v2u){0u, 0u}; bf16x8 qn0 = qf[0], qn1 = qf[1];
        if (hasn) { inext = *(const v2u*)((const unsigned short*)(F.ws + WS_IDX) + (size_t)tn * 256 + 4 * lane);
            const bf16* qrow = QKV + (size_t)tn * OD_INP + n * 64 + 8 * kb; qn0 = *(const bf16x8*)(qrow); qn1 = *(const bf16x8*)(qrow + 32); }
        float m = NEGF, l = 0.f;
        f32x4 o[4];
#pragma unroll
        for (int dt = 0; dt < 4; ++dt) o[dt] = (f32x4){0.f, 0.f, 0.f, 0.f};
        const int nck = (nv + 63) >> 6;
        for (int ck = 0; ck < nck; ++ck) {
            bool pre = false;
            if (ck + 1 < nck) { SP_GATHER(kn, vn, cur, (size_t)(t >> 13) * SEQ, ck + 1); pre = true; }
            else if (hasn) { const int tpn = tn & 8191, nvn = tpn + 1 < 256 ? tpn + 1 : 256; CBAR(); SP_TABS(cur ^ 1, inext, tpn, nvn); LDS_WAIT(); CBAR(); SP_GATHER(kn, vn, cur ^ 1, (size_t)(tn >> 13) * SEQ, 0); pre = true; }
            f32x4 sc[4]; float mx = NEGF;
#pragma unroll
            for (int jt = 0; jt < 4; ++jt) {
                f32x4 d = (f32x4){0.f, 0.f, 0.f, 0.f};
                d = __builtin_amdgcn_mfma_f32_16x16x32_bf16(kf[jt][0], qf[0], d, 0, 0, 0);
                d = __builtin_amdgcn_mfma_f32_16x16x32_bf16(kf[jt][1], qf[1], d, 0, 0, 0);
                const v4u bo = *(const LAS v4u*)(tabs + cur * 512 + 256 + 64 * ck + 16 * jt + 4 * kb);
#pragma unroll
                for (int i = 0; i < 4; ++i) { d[i] = d[i] * C2 + *(const LAS float*)((const LAS unsigned char*)rtab + bo[i] + 4 * n); mx = fmaxf(mx, d[i]); }
                sc[jt] = d; }
            mx = max16(mx); mx = max32(mx);
            const float mnew = fmaxf(m, mx), alpha = __builtin_amdgcn_exp2f(m - mnew);
            float rs = 0.f;
#pragma unroll
            for (int jt = 0; jt < 4; ++jt)
#pragma unroll
                for (int i = 0; i < 4; ++i) { sc[jt][i] = __builtin_amdgcn_exp2f(sc[jt][i] - mnew); rs += sc[jt][i]; }
            rs = sum16(rs); rs = sum32(rs);
            l = l * alpha + rs; m = mnew;
#pragma unroll
            for (int dt = 0; dt < 4; ++dt) o[dt] = o[dt] * alpha;
            CBAR();
#pragma unroll
            for (int i = 0; i < 8; ++i) { const int c = lane + 64 * i, key = c >> 3, ch = c & 7;
                *(LAS v4u*)(vbuf + (ch >> 1) * 2048 + key * 32 + (ch & 1) * 16) = vv[i]; }
            CBAR();
#pragma unroll
            for (int s2 = 0; s2 < 2; ++s2) {
                v4u pw; pw.x = pg8::cvt_pk_bf16(sc[2 * s2][0], sc[2 * s2][1]); pw.y = pg8::cvt_pk_bf16(sc[2 * s2][2], sc[2 * s2][3]); pw.z = pg8::cvt_pk_bf16(sc[2 * s2 + 1][0], sc[2 * s2 + 1][1]); pw.w = pg8::cvt_pk_bf16(sc[2 * s2 + 1][2], sc[2 * s2 + 1][3]);
                const bf16x8 pb = __builtin_bit_cast(bf16x8, pw);
                const LAS unsigned char* vb = vbuf + (32 * s2 + 4 * kb + q4) * 32 + 8 * p4;
#pragma unroll
                for (int dt = 0; dt < 4; ++dt) { const s16x4 lo = vtr(vb + dt * 2048), hh = vtr(vb + dt * 2048 + 16 * 32);
                    const bf16x8 va = (bf16x8){lo[0], lo[1], lo[2], lo[3], hh[0], hh[1], hh[2], hh[3]};
                    o[dt] = __builtin_amdgcn_mfma_f32_16x16x32_bf16(va, pb, o[dt], 0, 0, 0); } }
            CBAR();
            if (pre) {
#pragma unroll
                for (int jt = 0; jt < 4; ++jt) { kf[jt][0] = kn[jt][0]; kf[jt][1] = kn[jt][1]; }
#pragma unroll
                for (int i = 0; i < 8; ++i) vv[i] = vn[i]; }
        }
        const float inv = 1.f / l;
        if (PROJ_FP8) { unsigned char* o8p = (unsigned char*)(F.ws + WS_O) + (size_t)t * D + n * 64 + 4 * kb;
#pragma unroll
            for (int dt = 0; dt < 4; ++dt) *(unsigned*)(o8p + 16 * dt) = pk4_fp8(o[dt][0] * inv, o[dt][1] * inv, o[dt][2] * inv, o[dt][3] * inv); }
        else {
        bf16* op = (bf16*)(F.ws + WS_O) + (size_t)t * D + n * 64 + 4 * kb;
#pragma unroll
        for (int dt = 0; dt < 4; ++dt) { v2u w; w.x = pg8::cvt_pk_bf16(o[dt][0] * inv, o[dt][1] * inv); w.y = pg8::cvt_pk_bf16(o[dt][2] * inv, o[dt][3] * inv); *(v2u*)(op + 16 * dt) = w; } }
        cur ^= 1; qf[0] = qn0; qf[1] = qn1;
    }
#undef SP_GATHER
#undef SP_TABS
}

constexpr int N_PHASES = 2 + 9 * DEPTH;
struct Args { const float* in[19]; float* out; unsigned char* ws; int ph_lo, ph_hi; };
__global__ void __launch_bounds__(NWAVES * 64, 2) mk_fwd(Args args) {
    extern __shared__ __attribute__((aligned(16))) unsigned char lds[];
    Frame F;
    F.lds = (LAS unsigned char*)lds;
    F.tid = threadIdx.x; F.lane = F.tid & 63; F.wave = __builtin_amdgcn_readfirstlane(F.tid >> 6);
    F.G = gridDim.x; F.bid = blockIdx.x;
    F.XR = args.out; F.ws = args.ws;
    volatile LAS unsigned* MISC = (volatile LAS unsigned*)(F.lds + MISC_OFF);
    for (int u = F.tid; u < (LDS_BYTES - RING_BYTES) / 4; u += NWAVES * 64) ((LAS unsigned*)(F.lds + RING_BYTES))[u] = 0u;
    __syncthreads();
    (void)xcd_barrier_post((unsigned*)(F.ws + WS_CTL) + 1024, MISC + 8);
#if MK_SPLIT
    const int lo = args.ph_lo, hi = args.ph_hi;
#else
    constexpr int lo = 0, hi = N_PHASES;
#endif
#define IN(k) (lo <= (k) && (k) < hi)
#define LAUNDER() do { asm volatile("" : "+v"(F.tid)); F.lane = F.tid & 63; F.wave = __builtin_amdgcn_readfirstlane(F.tid >> 6); asm volatile("" : "+s"(F.ws), "+s"(F.bid), "+s"(F.G)); } while (0)
#define SEAM(k) do { if (IN((k) + 1)) { XcdBarrier b_; b_.bar = (unsigned*)(F.ws + WS_CTL) + 1024; b_.x = xb_xcc_id(); b_.st = (volatile LAS unsigned*)(F.lds + MISC_OFF) + 8; xcd_barrier(b_); } } while (0)

    if (IN(0)) { LAUNDER(); REP(0) { conv_small(F); conv_ffn(F, 0); mod_phase(F); } SEAM(0); }
    if (IN(1)) { LAUNDER(); REP(1) h0_phase(F); SEAM(1); }

#pragma nounroll
    for (int layer = 0; layer < DEPTH; ++layer) {
        const int pb = 2 + 9 * layer, li = layer >> 1; const bool odd = layer & 1;
        if (IN(pb + 0)) { LAUNDER();
            const int N = odd ? OD_INP : EV_IN;
            const bool f8 = !odd && PROJ_FP8;
            pg8::Gemm g{(const bf16*)(F.ws + WS_H), f8 ? (const bf16*)((const unsigned char*)(F.ws + WS_WINE) + (size_t)li * N * D) : (const bf16*)(F.ws + (odd ? WS_WINO : WS_WINE)) + (size_t)li * N * D, T, N, f8 ? D / 2 : D};
            REP(odd ? 11 : 2) {
            dense_units(F);
            pg8::GroupOrder S; S.init(T / 256, N / 256, F.G, F.bid, US);
            pg8::EpiOut E{1, (void*)(F.ws + WS_QKV), N, N / 256, nullptr, 0, nullptr, f8 ? (1.f / 32.f) : 1.f};
            if (f8) pg8::gemm_phase<pg8::EpiOut, pg8::GroupOrder, true, true, true>(F.lds, g, S, E, F.tid);
            else pg8::gemm_phase<pg8::EpiOut, pg8::GroupOrder, true, true, false>(F.lds, g, S, E, F.tid); }
            SEAM(pb + 0);
        }
        if (IN(pb + 1)) { LAUNDER();
#ifndef SKIP_BAND
            if (!odd) REP(3) band_phase(F, li);
#endif
#ifndef SKIP_IDX
            if (odd) REP(12) indexer_phase(F);
#endif
            SEAM(pb + 1); }
        if (IN(pb + 2)) { LAUNDER();
#ifndef SKIP_SPARSE
            if (odd) { REP(13) sparse_phase(F); SEAM(pb + 2); }
#endif
        }
        if (IN(pb + 3)) { LAUNDER();
            __syncthreads();
            pg8::Gemm g{(const bf16*)(F.ws + WS_O), PROJ_FP8 ? (const bf16*)((const unsigned char*)(F.ws + (odd ? WS_WOO : WS_WOE)) + (size_t)li * D * D) : (const bf16*)(F.ws + (odd ? WS_WOO : WS_WOE)) + (size_t)li * D * D, T, D, PROJ_FP8 ? D / 2 : D};
            dense_units(F);
            pg8::GroupOrder S; S.init(T / 256, D / 256, F.G, F.bid, US);
            pg8::EpiOut E{0, (void*)(F.ws + WS_XH), 0, D / 256, layer == 0 ? (const void*)inp<I_X>() : (const void*)(F.ws + WS_XH), layer == 0 ? 1 : 0, mod_ptr(F, layer * 2, 2, 0), PROJ_FP8 ? (1.f / 64.f) : 1.f};
            pg8::gemm_phase<pg8::EpiOut, pg8::GroupOrder, true, true, (PROJ_FP8 != 0)>(F.lds, g, S, E, F.tid);
            SEAM(pb + 3);
        }
        if (IN(pb + 4)) { LAUNDER(); if (!odd) ln_phase<0>(F, layer, 0, false); else ln_phase<1>(F, layer, 0, false); SEAM(pb + 4); }
        if (IN(pb + 5)) { LAUNDER(); if (odd) { REP(16) gather_phase(F, layer); SEAM(pb + 5); } }
        if (IN(pb + 6)) { LAUNDER();
            REP(odd ? 17 : 8) {
            if (odd) moe_units(F); else dense_units(F);
            pg8::GroupOrder S; S.init(US[8], 2 * FF / 256, F.G, F.bid, US);
            const bool f8 = odd ? UP_FP8_MOE : UP_FP8_DENSE;
            pg8::Gemm g{(const bf16*)(F.ws + (odd ? WS_XB : WS_H)), (const bf16*)(F.ws + WS_W13), T, 2 * FF, f8 ? D / 2 : D};
            pg8::EpiSwiGLU E{(bf16*)(F.ws + (odd ? WS_UM : WS_U)), FF, 2 * FF / 256, nullptr, f8 ? (1.f / 32.f) : 1.f, (odd ? DOWN_FP8_MOE : DOWN_FP8_DENSE) ? 1 : 0};
            if (f8) pg8::gemm_phase<pg8::EpiSwiGLU, pg8::GroupOrder, true, true, true>(F.lds, g, S, E, F.tid);
            else pg8::gemm_phase<pg8::EpiSwiGLU, pg8::GroupOrder, true, true, false>(F.lds, g, S, E, F.tid); }
            SEAM(pb + 6);
        }
        if (IN(pb + 7)) { LAUNDER();
            if (odd) moe_units(F); else dense_units(F);
            pg8::GroupOrder S; S.init(US[8], D / 256, F.G, F.bid, US);
            const bool f8 = odd ? DOWN_FP8_MOE : DOWN_FP8_DENSE;
            pg8::Gemm g{(const bf16*)(F.ws + (odd ? WS_UM : WS_U)), (const bf16*)(F.ws + WS_W2), T, D, f8 ? FF / 2 : FF};
            pg8::EpiOut E{odd ? 1 : 0, odd ? (void*)(F.ws + WS_XB) : (void*)(F.ws + WS_XH), D, D / 256, (const void*)(F.ws + WS_XH), 0, mod_ptr(F, layer * 2 + 1, 2, 0), f8 ? (1.f / 128.f) : 1.f};
            if (f8) pg8::gemm_phase<pg8::EpiOut, pg8::GroupOrder, true, true, true>(F.lds, g, S, E, F.tid);
            else pg8::gemm_phase<pg8::EpiOut, pg8::GroupOrder, true, true, false>(F.lds, g, S, E, F.tid);
            SEAM(pb + 7);
        }
        if (IN(pb + 8)) { LAUNDER();
            __syncthreads();
            if (!odd) ln_phase<0>(F, layer, 1, layer == DEPTH - 1); else ln_phase<2>(F, layer, 1, layer == DEPTH - 1);
            if (layer + 1 < DEPTH) { __syncthreads(); conv_ffn(F, layer + 1); }
            SEAM(pb + 8);
        }
    }
#undef IN
#undef SEAM
}

extern "C" void kernel_launch(void* const* d_in, const int* in_sizes, int n_in, void* d_out, int out_size, void* d_ws, size_t ws_size, hipStream_t stream) {
    static int grid = 0;
    if (grid == 0) {
        if (n_in != 19 || out_size != T * D || ws_size < WS_END) { fprintf(stderr, "kernel_launch: unexpected shapes (n_in %d out %d ws %zu need %zu)\n", n_in, out_size, ws_size, (size_t)WS_END); grid = -1; return; }
        int dev = 0, cus = 0;
        if (hipGetDevice(&dev) != hipSuccess || hipDeviceGetAttribute(&cus, hipDeviceAttributeMultiprocessorCount, dev) != hipSuccess) { grid = -1; return; }
        if (hipFuncSetAttribute((const void*)mk_fwd, hipFuncAttributeMaxDynamicSharedMemorySize, LDS_BYTES) != hipSuccess) { grid = -1; return; }
        int per_cu = 0;
        (void)hipOccupancyMaxActiveBlocksPerMultiprocessor(&per_cu, (const void*)mk_fwd, NWAVES * 64, LDS_BYTES);
        (void)hipGetLastError();
        grid = cus;
        if (grid != 256) fprintf(stderr, "kernel_launch: built for 256 CUs, got %d\n", grid);
    }
    if (grid < 0) return;
    (void)hipMemsetAsync((char*)d_ws + WS_CTL, 0, CTL_ZERO_BYTES, stream);
    Args a{};
    for (int i = 0; i < 19; ++i) a.in[i] = (const float*)d_in[i];
    a.out = (float*)d_out; a.ws = (unsigned char*)d_ws;
#if MK_SPLIT
    for (int p = 0; p < N_PHASES; ++p) { a.ph_lo = p; a.ph_hi = p + 1; hipLaunchKernelGGL(mk_fwd, dim3(grid), dim3(NWAVES * 64), LDS_BYTES, stream, a); }
#else
    a.ph_lo = 0; a.ph_hi = N_PHASES;
    hipLaunchKernelGGL(mk_fwd, dim3(grid), dim3(NWAVES * 64), LDS_BYTES, stream, a);
#endif
}

#ifdef PHASE_TEST
#define MK_TEST_KERNEL(name, body) __global__ void __launch_bounds__(512, 2) name(Args args) { extern __shared__ __attribute__((aligned(16))) unsigned char lds[]; Frame F; F.lds = (LAS unsigned char*)lds; \
    F.tid = threadIdx.x; F.lane = F.tid & 63; F.wave = __builtin_amdgcn_readfirstlane(F.tid >> 6); F.G = gridDim.x; F.bid = blockIdx.x; F.XR = args.out; F.ws = args.ws; body; }
MK_TEST_KERNEL(t_band, band_phase(F, 0))
MK_TEST_KERNEL(t_idx, indexer_phase(F))
MK_TEST_KERNEL(t_sparse, sparse_phase(F))
MK_TEST_KERNEL(t_ln0, ln_phase<0>(F, 0, 0, false))
MK_TEST_KERNEL(t_ln1, ln_phase<1>(F, 1, 0, false))
MK_TEST_KERNEL(t_ln2, ln_phase<2>(F, 1, 1, false))
MK_TEST_KERNEL(t_gather, gather_phase(F, 1))
MK_TEST_KERNEL(t_p0, conv_small(F); conv_ffn(F, 0); mod_phase(F))
#endif
```

```cpp
#include <hip/hip_runtime.h>
#include <cstdio>
#include <cstdint>

#ifndef PROBE_MASK
#define PROBE_MASK 0
#endif
#ifndef AM_E
#define AM_E 1.f
#endif
#ifndef AM_O
#define AM_O 1.f
#endif
#ifndef AM_F
#define AM_F 1.f
#endif
#ifndef AM_M
#define AM_M 1.f
#endif
#ifndef REPEAT_CAT
#define REPEAT_CAT -1
#endif
#define REP(c) for (int rep_ = 0; rep_ < ((REPEAT_CAT == (c)) ? 2 : 1); ++rep_)
#ifndef PROBE_DBG
#define PROBE_DBG 0
#endif
#ifndef UP_FP8_DENSE
#define UP_FP8_DENSE 1
#endif
#ifndef UP_FP8_MOE
#define UP_FP8_MOE 1
#endif
#ifndef DOWN_FP8_DENSE
#define DOWN_FP8_DENSE 1
#endif
#ifndef DOWN_FP8_MOE
#define DOWN_FP8_MOE 1
#endif
#ifndef PROJ_FP8
#define PROJ_FP8 1
#endif
#ifndef MK_SPLIT
#define MK_SPLIT 0
#endif

namespace pg8 {
#define PG8_LAS __attribute__((address_space(3)))
typedef unsigned short bf16_t;
typedef short bf16x8 __attribute__((ext_vector_type(8)));
typedef float f32x4 __attribute__((ext_vector_type(4)));
typedef unsigned u32x4 __attribute__((ext_vector_type(4)));
constexpr int BM = 256, BK = 64, HALF = 128, HTB = HALF * BK * 2, STAGE_BYTES = 8 * HTB, NXCD = 8, WGM = 8;

__host__ __device__ __forceinline__ int lds_byte(int r, int c) { const int st = (r >> 4) * 2 + (c >> 5), rr = r & 15, cc = c & 31, ob = rr * 64 + cc * 2; return st * 1024 + (ob ^ (((ob >> 9) & 1) << 5)); }
__host__ __device__ __forceinline__ void stage_rc(int b, int& R, int& C) { const int st = b / 1024, sb = b % 1024, swz = sb ^ (((sb >> 9) & 1) << 5); R = (st >> 1) * 16 + swz / 64; C = (st & 1) * 32 + (swz % 64) / 2; }
__host__ __device__ __forceinline__ int perm32(int rho) { const int n = rho >> 4, i = rho & 15; return 8 * (i >> 2) + 4 * n + (i & 3); }

struct Unit { int pm, pn; };
struct Gemm { const bf16_t* A; const bf16_t* Bt; int M, N, K; };

struct GroupOrder {
    int nM, nN, nwg, G, c; const PG8_LAS int* us;
    __device__ __forceinline__ void init(int nM_, int nN_, int G_, int c_, const PG8_LAS int* us_) { nM = nM_; nN = nN_; nwg = nM * nN; G = G_; c = c_; us = us_; }
    __device__ __forceinline__ bool next(int i, Unit& u) const {
        const long L = (long)i * G + c; if (L >= nwg) return false;
        int wgid = (int)L; { const int q = nwg / NXCD, r = nwg % NXCD, xcd = wgid % NXCD, off = wgid / NXCD; wgid = (xcd < r ? xcd * (q + 1) : r * (q + 1) + (xcd - r) * q) + off; }
        const int nig = WGM * nN, gid = wgid / nig, fm = gid * WGM, gsz = (nM - fm) < WGM ? (nM - fm) : WGM;
        const int pm = fm + ((wgid % nig) % gsz), pn = (wgid % nig) / gsz;
        int e = 0;
#pragma unroll
        for (int k = 1; k < 8; ++k) e += (us[k] <= pm) ? 1 : 0;
        u.pm = pm; u.pn = e * nN + pn; return true;
    }
    __device__ __forceinline__ void a_ready(const Unit&) const {}
    __device__ __forceinline__ void done(const Unit&) const {}
};

__device__ __forceinline__ unsigned cvt_pk_bf16(float lo, float hi) { unsigned r; asm volatile("v_cvt_pk_bf16_f32 %0, %1, %2" : "=v"(r) : "v"(lo), "v"(hi)); return r; }

struct EpiOut {
    static constexpr bool PERM = true, AFTER_DRAIN = false;
    int mode; void* P; int ldc; int nNe; const void* X; int xf32; const float* gate; float osc;
    __device__ __forceinline__ void operator()(const f32x4 (&acc)[2][2][4][2], const Unit& u, int wr, int wc, int fr, int fq) const {
        const int row0 = u.pm * BM + wr * 64 + fr; const int colt = (u.pn % nNe) * BM + wc * 32 + 8 * fq;
        if (mode == 1) {
#pragma unroll
            for (int ai = 0; ai < 2; ++ai)
#pragma unroll
                for (int m = 0; m < 4; ++m) { bf16_t* rowp = (bf16_t*)P + (size_t)(row0 + ai * HALF + m * 16) * ldc + colt;
#pragma unroll
                    for (int bj = 0; bj < 2; ++bj) { const f32x4 v0 = acc[ai][bj][m][0] * osc, v1 = acc[ai][bj][m][1] * osc;
                        u32x4 w; w.x = cvt_pk_bf16(v0[0], v0[1]); w.y = cvt_pk_bf16(v0[2], v0[3]); w.z = cvt_pk_bf16(v1[0], v1[1]); w.w = cvt_pk_bf16(v1[2], v1[3]);
                        *(u32x4*)(rowp + bj * HALF) = w;
 } }
        } else {
            const float* gp = gate + (size_t)((u.pm * BM) >> 13) * 1024 + colt;
            f32x4 gv[2][2];
#pragma unroll
            for (int bj = 0; bj < 2; ++bj)
#pragma unroll
                for (int n = 0; n < 2; ++n) gv[bj][n] = *(const f32x4*)(gp + bj * HALF + 4 * n);
            const float am = osc;
#pragma unroll
            for (int ai = 0; ai < 2; ++ai)
#pragma unroll
                for (int m = 0; m < 4; ++m) { const size_t ro = (size_t)(row0 + ai * HALF + m * 16) * 1024 + colt;
#pragma unroll
                    for (int bj = 0; bj < 2; ++bj) { f32x4 x0, x1;
                        if (xf32) { x0 = *(const f32x4*)((const float*)X + ro + bj * HALF); x1 = *(const f32x4*)((const float*)X + ro + bj * HALF + 4); }
                        else { const u32x4 xw = *(const u32x4*)((const bf16_t*)X + ro + bj * HALF);
                            x0 = (f32x4){__builtin_bit_cast(float, xw.x << 16), __builtin_bit_cast(float, xw.x & 0xffff0000u), __builtin_bit_cast(float, xw.y << 16), __builtin_bit_cast(float, xw.y & 0xffff0000u)};
                            x1 = (f32x4){__builtin_bit_cast(float, xw.z << 16), __builtin_bit_cast(float, xw.z & 0xffff0000u), __builtin_bit_cast(float, xw.w << 16), __builtin_bit_cast(float, xw.w & 0xffff0000u)}; }
                        const f32x4 y0 = x0 * 1.681792830507429f + gv[bj][0] * (acc[ai][bj][m][0] * am), y1 = x1 * 1.681792830507429f + gv[bj][1] * (acc[ai][bj][m][1] * am);
                        u32x4 w; w.x = cvt_pk_bf16(y0[0], y0[1]); w.y = cvt_pk_bf16(y0[2], y0[3]); w.z = cvt_pk_bf16(y1[0], y1[1]); w.w = cvt_pk_bf16(y1[2], y1[3]);
                        *(u32x4*)((bf16_t*)P + ro + bj * HALF) = w; } }
        }
    }
};
struct EpiSwiGLU {
    static constexpr bool PERM = true, AFTER_DRAIN = false;
    bf16_t* U; int ldc; int nNe; float* dbg; float sc; int o8;
    __device__ __forceinline__ void operator()(const f32x4 (&acc)[2][2][4][2], const Unit& u, int wr, int wc, int fr, int fq) const {
        const int row0 = u.pm * BM + wr * 64 + fr; const int colt = (u.pn % nNe) * HALF + wc * 32 + 8 * fq;
        const float nk = -1.4426950408889634f * sc, isc2 = 1.f / (sc * sc);
#pragma unroll
        for (int ai = 0; ai < 2; ++ai)
#pragma unroll
            for (int m = 0; m < 4; ++m) { float r[8];
#pragma unroll
                for (int n = 0; n < 2; ++n)
#pragma unroll
                    for (int e = 0; e < 4; ++e) { const float a = acc[ai][0][m][n][e], b = acc[ai][1][m][n][e];
                        r[4 * n + e] = (a * b) * __builtin_amdgcn_rcpf(__builtin_fmaf(__builtin_amdgcn_exp2f(nk * a), isc2, isc2)); }
                if (o8) { typedef unsigned u32x2_ __attribute__((ext_vector_type(2))); u32x2_ w8;
                    int p0 = __builtin_amdgcn_cvt_pk_fp8_f32(r[0], r[1], 0, false); p0 = __builtin_amdgcn_cvt_pk_fp8_f32(r[2], r[3], p0, true);
                    int p1 = __builtin_amdgcn_cvt_pk_fp8_f32(r[4], r[5], 0, false); p1 = __builtin_amdgcn_cvt_pk_fp8_f32(r[6], r[7], p1, true);
                    w8.x = (unsigned)p0; w8.y = (unsigned)p1; *(u32x2_*)((unsigned char*)U + (size_t)(row0 + ai * HALF + m * 16) * ldc + colt) = w8; }
                else {
                u32x4 w; w.x = cvt_pk_bf16(r[0], r[1]); w.y = cvt_pk_bf16(r[2], r[3]); w.z = cvt_pk_bf16(r[4], r[5]); w.w = cvt_pk_bf16(r[6], r[7]);
                *(u32x4*)(U + (size_t)(row0 + ai * HALF + m * 16) * ldc + colt) = w; }
                if (dbg) { float t_ = 0.f;
#pragma unroll
                    for (int k = 0; k < 8; ++k) t_ += __builtin_fabsf(r[k]);
#pragma unroll
                    for (int o = 1; o < 64; o <<= 1) t_ += __shfl_xor(t_, o);
                    if ((fr | fq) == 0) atomicAdd(dbg, t_ * (1.f / (65536.f * 3584.f))); } }
    }
};

template <class Epi, class Sched, bool ALIGN_EPI = false, bool SP2 = false, bool FP8 = false>
__device__ __forceinline__ void gemm_phase(PG8_LAS unsigned char* lds, const Gemm g, const Sched& S, const Epi& E, const int tid) {
    const int wid = __builtin_amdgcn_readfirstlane(tid >> 6), lane = tid & 63, wr = wid >> 2, wc = wid & 3, fr = lane & 15, fq = lane >> 4;
    const int K = g.K, nt = K / BK;
    unsigned voffA[2], voffB[2];
#pragma unroll
    for (int i = 0; i < 2; ++i) { int R, C; stage_rc(tid * 16 + i * 8192, R, C); const int Rb = Epi::PERM ? ((R & ~31) + perm32(R & 31)) : R;
        voffA[i] = (unsigned)(R * K + C) * 2u; voffB[i] = (unsigned)(Rb * K + C) * 2u; }
    const size_t kstep = (size_t)(BK * 2);
    const size_t hstep = (size_t)HALF * K * 2;
    const size_t tstep = 2 * hstep;
    const unsigned ldsw = (unsigned)wid * 1024u;
    const int aoff = lds_byte(wr * 64 + fr, fq * 8), boff = lds_byte(wc * 32 + fr, fq * 8);
#define PG8_SA(b, h) (((b) * 2 + (h)) * HTB)
#define PG8_SB(b, h) ((4 + (b) * 2 + (h)) * HTB)
#define PG8_STAGE(bufoff, gbase, voff) do { _Pragma("unroll") for (int _i = 0; _i < 2; ++_i) \
        __builtin_amdgcn_global_load_lds((const unsigned*)((const char*)(gbase) + (voff)[_i]), (PG8_LAS unsigned*)(lds + (bufoff) + ldsw + _i * 8192), 16, 0, 0); } while (0)
#define PG8_LDA(dst, b, h) do { _Pragma("unroll") for (int m = 0; m < 4; ++m) { if constexpr (FP8) { dst##8[m].lo = *(const PG8_LAS v4i_*)(lds + PG8_SA(b, h) + aoff + m * 2048); dst##8[m].hi = *(const PG8_LAS v4i_*)(lds + PG8_SA(b, h) + aoff + m * 2048 + 1024); } \
        else { _Pragma("unroll") for (int k = 0; k < 2; ++k) dst[m][k] = *(const PG8_LAS bf16x8*)(lds + PG8_SA(b, h) + aoff + m * 2048 + k * 1024); } } } while (0)
#define PG8_LDB(dst, b, h) do { _Pragma("unroll") for (int n = 0; n < 2; ++n) { if constexpr (FP8) { dst##8[n].lo = *(const PG8_LAS v4i_*)(lds + PG8_SB(b, h) + boff + n * 2048); dst##8[n].hi = *(const PG8_LAS v4i_*)(lds + PG8_SB(b, h) + boff + n * 2048 + 1024); } \
        else { _Pragma("unroll") for (int k = 0; k < 2; ++k) dst[n][k] = *(const PG8_LAS bf16x8*)(lds + PG8_SB(b, h) + boff + n * 2048 + k * 1024); } } } while (0)
#define PG8_MMA(ai, bj, At, Bt) do { __builtin_amdgcn_s_setprio(1); _Pragma("unroll") for (int m = 0; m < 4; ++m) _Pragma("unroll") for (int n = 0; n < 2; ++n) { \
        if constexpr (FP8) asm volatile("v_mfma_scale_f32_16x16x128_f8f6f4 %0, %1, %2, %0, %3, %3 op_sel_hi:[0,0,0]" : "+v"(acc[ai][bj][m][n]) : "v"(Bt##8[n]), "v"(At##8[m]), "v"(sc127)); \
        else { _Pragma("unroll") for (int k = 0; k < 2; ++k) acc[ai][bj][m][n] = __builtin_amdgcn_mfma_f32_16x16x32_bf16(Bt[n][k], At[m][k], acc[ai][bj][m][n], 0, 0, 0); } } \
        __builtin_amdgcn_s_setprio(0); } while (0)
#define PG8_WAIT_V(n) asm volatile("s_waitcnt vmcnt(" #n ")" ::: "memory")
#define PG8_WAIT_L(n) asm volatile("s_waitcnt lgkmcnt(" #n ")" ::: "memory")
#define PG8_BAR __builtin_amdgcn_s_barrier()
#define PG8_SCHED __builtin_amdgcn_sched_barrier(0)
    Unit cur, nxt; int ui = 0;
    if (!S.next(0, cur)) return;
    f32x4 acc[2][2][4][2];
#pragma unroll
    for (int a = 0; a < 2; ++a)
#pragma unroll
        for (int b = 0; b < 2; ++b)
#pragma unroll
            for (int m = 0; m < 4; ++m)
#pragma unroll
                for (int n = 0; n < 2; ++n) acc[a][b][m][n] = (f32x4){0.f, 0.f, 0.f, 0.f};
    typedef int v4i_ __attribute__((ext_vector_type(4))); typedef int v8i_ __attribute__((ext_vector_type(8)));
    bf16x8 At[4][2], B0[2][2], B1[2][2]; v8i_ At8[4], B08[2], B18[2]; const int sc127 = 127;
    const char* cA = (const char*)g.A + (size_t)cur.pm * tstep; const char* cB = (const char*)g.Bt + (size_t)cur.pn * tstep;
    S.a_ready(cur);
    if constexpr (SP2) {
        PG8_STAGE(PG8_SB(0, 0), cB, voffB); PG8_STAGE(PG8_SB(0, 1), cB + hstep, voffB); PG8_STAGE(PG8_SA(0, 0), cA, voffA); PG8_STAGE(PG8_SA(0, 1), cA + hstep, voffA);
        if (wr == 1) PG8_BAR;
        PG8_WAIT_V(2); PG8_BAR;
        PG8_STAGE(PG8_SB(1, 0), cB + kstep, voffB); PG8_STAGE(PG8_SA(1, 0), cA + kstep, voffA); PG8_STAGE(PG8_SB(1, 1), cB + hstep + kstep, voffB);
        PG8_WAIT_V(6); PG8_BAR;
    } else {
        PG8_STAGE(PG8_SB(0, 0), cB, voffB); PG8_STAGE(PG8_SA(0, 0), cA, voffA); PG8_STAGE(PG8_SB(0, 1), cB + hstep, voffB); PG8_STAGE(PG8_SA(0, 1), cA + hstep, voffA);
        if (wr == 1) PG8_BAR;
        PG8_WAIT_V(4); PG8_BAR;
        PG8_STAGE(PG8_SB(1, 0), cB + kstep, voffB); PG8_STAGE(PG8_SA(1, 0), cA + kstep, voffA); PG8_STAGE(PG8_SB(1, 1), cB + hstep + kstep, voffB);
        PG8_WAIT_V(6); PG8_BAR;
    }
    for (;;) {
        const bool has_next = S.next(ui + 1, nxt);
        const char* nA = has_next ? (const char*)g.A + (size_t)nxt.pm * tstep : cA; const char* nB = has_next ? (const char*)g.Bt + (size_t)nxt.pn * tstep : cB;
        for (int t = 0; t < nt; t += 2) {
            const bool last = (t == nt - 2);
            const char* a1 = cA + (size_t)(t + 1) * kstep;
            const char* a2 = last ? nA : cA + (size_t)(t + 2) * kstep; const char* b2 = last ? nB : cB + (size_t)(t + 2) * kstep;
            const char* a3 = a2 + kstep; const char* b3 = b2 + kstep;
            if (last && has_next) S.a_ready(nxt);
            if constexpr (SP2) {
            PG8_LDB(B0, 0, 0); PG8_LDB(B1, 0, 1); PG8_SCHED; PG8_LDA(At, 0, 0); PG8_STAGE(PG8_SA(1, 1), a1 + hstep, voffA);
            PG8_WAIT_V(8); PG8_WAIT_L(0); PG8_BAR; PG8_MMA(0, 0, At, B0); PG8_MMA(0, 1, At, B1); PG8_BAR; PG8_SCHED;
            PG8_LDA(At, 0, 1); PG8_STAGE(PG8_SB(0, 0), b2, voffB); PG8_STAGE(PG8_SB(0, 1), b2 + hstep, voffB); PG8_STAGE(PG8_SA(0, 0), a2, voffA);
            PG8_WAIT_V(8); PG8_WAIT_L(0); PG8_BAR; PG8_MMA(1, 0, At, B0); PG8_MMA(1, 1, At, B1); PG8_BAR; PG8_SCHED;
            PG8_LDB(B0, 1, 0); PG8_LDB(B1, 1, 1); PG8_SCHED; PG8_LDA(At, 1, 0); PG8_STAGE(PG8_SA(0, 1), a2 + hstep, voffA);
            PG8_WAIT_V(8); PG8_WAIT_L(0); PG8_BAR; PG8_MMA(0, 0, At, B0); PG8_MMA(0, 1, At, B1); PG8_BAR; PG8_SCHED;
            PG8_LDA(At, 1, 1); PG8_STAGE(PG8_SB(1, 0), b3, voffB); PG8_STAGE(PG8_SB(1, 1), b3 + hstep, voffB); PG8_STAGE(PG8_SA(1, 0), a3, voffA);
            PG8_WAIT_V(8); PG8_WAIT_L(0); PG8_BAR; PG8_MMA(1, 0, At, B0); PG8_MMA(1, 1, At, B1); PG8_BAR; PG8_SCHED;
            } else {
            PG8_LDB(B0, 0, 0); PG8_SCHED; PG8_LDA(At, 0, 0); PG8_STAGE(PG8_SA(1, 1), a1 + hstep, voffA);
            PG8_WAIT_L(8); PG8_BAR; PG8_WAIT_L(0); PG8_MMA(0, 0, At, B0); PG8_BAR; PG8_SCHED;
            PG8_LDB(B1, 0, 1); PG8_STAGE(PG8_SB(0, 0), b2, voffB);
            PG8_BAR; PG8_WAIT_L(0); PG8_MMA(0, 1, At, B1); PG8_BAR;
            PG8_LDA(At, 0, 1); PG8_STAGE(PG8_SA(0, 0), a2, voffA);
            PG8_BAR; PG8_WAIT_L(0); PG8_MMA(1, 0, At, B0); PG8_BAR; PG8_SCHED;
            PG8_STAGE(PG8_SB(0, 1), b2 + hstep, voffB);
            PG8_WAIT_V(6); PG8_BAR; PG8_MMA(1, 1, At, B1); PG8_BAR;
            PG8_LDB(B0, 1, 0); PG8_SCHED; PG8_LDA(At, 1, 0); PG8_STAGE(PG8_SA(0, 1), a2 + hstep, voffA);
            PG8_WAIT_L(8); PG8_BAR; PG8_WAIT_L(0); PG8_MMA(0, 0, At, B0); PG8_BAR; PG8_SCHED;
            PG8_LDB(B1, 1, 1); PG8_STAGE(PG8_SB(1, 0), b3, voffB);
            PG8_BAR; PG8_WAIT_L(0); PG8_MMA(0, 1, At, B1); PG8_BAR;
            PG8_LDA(At, 1, 1); PG8_STAGE(PG8_SA(1, 0), a3, voffA);
            PG8_BAR; PG8_WAIT_L(0); PG8_MMA(1, 0, At, B0); PG8_BAR; PG8_SCHED;
            PG8_STAGE(PG8_SB(1, 1), b3 + hstep, voffB);
            PG8_WAIT_V(6); PG8_BAR; PG8_MMA(1, 1, At, B1); PG8_BAR;
            }
        }
        if constexpr (ALIGN_EPI) { if (wr == 0) PG8_BAR; }
        if constexpr (!Epi::AFTER_DRAIN) { E(acc, cur, wr, wc, fr, fq); S.done(cur); }
        if (!has_next) break;
#pragma unroll
        for (int a = 0; a < 2; ++a)
#pragma unroll
            for (int b = 0; b < 2; ++b)
#pragma unroll
                for (int m = 0; m < 4; ++m)
#pragma unroll
                    for (int n = 0; n < 2; ++n) acc[a][b][m][n] = (f32x4){0.f, 0.f, 0.f, 0.f};
        cur = nxt; cA = nA; cB = nB; ++ui;
        if constexpr (ALIGN_EPI) { if (wr == 1) PG8_BAR; }
    }
    PG8_WAIT_V(0);
    if constexpr (!ALIGN_EPI) { if (wr == 0) PG8_BAR; }
    PG8_BAR;
#undef PG8_SA
#undef PG8_SB
#undef PG8_STAGE
#undef PG8_LDA
#undef PG8_LDB
#undef PG8_MMA
#undef PG8_WAIT_V
#undef PG8_WAIT_L
#undef PG8_BAR
#undef PG8_SCHED
}
}

constexpr int NB = 4, SEQ = 8192, T = NB * SEQ, D = 1024, FF = 3584, NE = 8, DEPTH = 4;
constexpr int EV_IN = 2304, OD_IN = 1736, OD_INP = 1792;
constexpr int PMAX = 2 * T + NE * 256;
constexpr float ALPHA = 1.681792830507429f;
constexpr float LN_EPS = 1e-5f;
constexpr float LOG2E = 1.4426950408889634f, C2 = 0.125f * 1.4426950408889634f;
constexpr float WIS = 0.04419417382415922f;
constexpr float NEGF = -1e30f;
constexpr int NWAVES = 8;

constexpr size_t MiB = 1u << 20;
constexpr size_t WS_CTL = 0, CTL_ZERO_BYTES = 64 * 1024;
constexpr size_t WS_MOD = 1 * MiB;
constexpr size_t WS_CNTG = WS_MOD + 512 * 1024;
constexpr size_t WS_CNTW = WS_CNTG + 16 * 1024;
constexpr size_t WS_RT_E = 128 * 1024, WS_RT_G = 384 * 1024, WS_RT_S = 640 * 1024;
constexpr size_t WS_ROUTE_UNUSED = 0;
constexpr size_t WS_WINE = 2 * MiB, WS_WOE = 11 * MiB, WS_WINO = 15 * MiB, WS_WOO = 22 * MiB;
constexpr size_t WS_W13 = 26 * MiB, WS_W2 = 138 * MiB;
constexpr size_t WS_H = 194 * MiB;
constexpr size_t WS_AR = 258 * MiB;
constexpr size_t WS_QKV = WS_AR;
constexpr size_t WS_IDX = WS_AR + 112 * MiB;
constexpr size_t WS_O = WS_AR + 144 * MiB;
constexpr size_t WS_PART = WS_AR + 208 * MiB;
constexpr size_t WS_LSE = WS_AR + 304 * MiB;
constexpr size_t WS_SCR = WS_AR + 208 * MiB;
constexpr size_t WS_U = WS_AR;
constexpr size_t WS_XB = WS_AR;
constexpr size_t WS_UM = WS_AR + 132 * MiB;
constexpr size_t WS_XH = WS_UM + (size_t)PMAX * FF * 2;
constexpr size_t WS_END = WS_XH + (size_t)T * D * 2;
static_assert(WS_END <= 920 * MiB, "d_ws map");

constexpr int RING_BYTES = 131072;
constexpr int MISC_OFF = RING_BYTES + 320;
constexpr int LDS_BYTES = 147456;

#define GAS __attribute__((address_space(1)))
#define LAS __attribute__((address_space(3)))
typedef unsigned short bf16;
typedef unsigned v4u __attribute__((ext_vector_type(4)));
typedef unsigned v2u __attribute__((ext_vector_type(2)));
typedef float f32x4 __attribute__((ext_vector_type(4)));
typedef float f32x16 __attribute__((ext_vector_type(16)));
typedef short bf16x8 __attribute__((ext_vector_type(8)));
typedef short s16x4 __attribute__((ext_vector_type(4)));
typedef GAS unsigned gu32;
#define RLX_AGENT __ATOMIC_RELAXED, __HIP_MEMORY_SCOPE_AGENT
#define LDS_WAIT() asm volatile("s_waitcnt lgkmcnt(0)" ::: "memory")
#define VM_WAIT() asm volatile("s_waitcnt vmcnt(0)" ::: "memory")
#define CBAR() asm volatile("" ::: "memory")
__device__ __forceinline__ unsigned f2bf(float f) { unsigned u = __builtin_bit_cast(unsigned, f); return (u + 0x7fffu + ((u >> 16) & 1u)) >> 16; }
__device__ __forceinline__ unsigned pk2(float lo, float hi) { return f2bf(lo) | (f2bf(hi) << 16); }
__device__ __forceinline__ unsigned pk4_fp8(float a, float b, float c, float d) { int p = __builtin_amdgcn_cvt_pk_fp8_f32(a, b, 0, false); p = __builtin_amdgcn_cvt_pk_fp8_f32(c, d, p, true); return (unsigned)p; }
__device__ __forceinline__ float bf2f(unsigned b) { return __builtin_bit_cast(float, b << 16); }
__device__ __forceinline__ float bflo(unsigned w) { return __builtin_bit_cast(float, w << 16); }
__device__ __forceinline__ float bfhi(unsigned w) { return __builtin_bit_cast(float, w & 0xffff0000u); }

#define XB_TMO      128
#define XB_XCNT(j)  (256  + 64 * (j))
#define XB_XSUB(j)  (1280 + 64 * (j))
#define XB_XGEN(j)  (2304 + 64 * (j))
#define XB_TOP      3328
#define XB_TOPGEN   3392
#define XCD_BAR_WORDS 3456
#define XB_SPIN_CAP (1u << 20)
__device__ __forceinline__ unsigned xb_ld(unsigned* p)              { return __hip_atomic_load(p, __ATOMIC_RELAXED, __HIP_MEMORY_SCOPE_AGENT); }
__device__ __forceinline__ unsigned xb_add(unsigned* p, unsigned v) { return __hip_atomic_fetch_add(p, v, __ATOMIC_RELAXED, __HIP_MEMORY_SCOPE_AGENT); }
__device__ __forceinline__ unsigned xb_xcc_id() { return (unsigned)__builtin_amdgcn_s_getreg((3 << 11) | 20) & 0xFu; }
#define XB_SPIN(cond, bar) do { unsigned _sp = 0; while (cond) { __builtin_amdgcn_s_sleep(1); \
    if ((++_sp & 255u) == 0u) { if (xb_ld(&(bar)[XB_TMO])) break; if (_sp > XB_SPIN_CAP) { atomicAdd(&(bar)[XB_TMO], 1u); break; } } } } while (0)
struct XcdBarrier { unsigned* bar; unsigned x; volatile LAS unsigned* st; };
__device__ __forceinline__ XcdBarrier xcd_barrier_post(unsigned* bar, volatile LAS unsigned* st) {
    XcdBarrier b; b.bar = bar; b.x = xb_xcc_id(); b.st = st;
    if (threadIdx.x == 0) (void)xb_add(&bar[XB_XCNT(b.x)], 1u);
    return b;
}
__device__ __forceinline__ void xcd_barrier_complete(unsigned* bar, unsigned x, unsigned& nloc, unsigned& nx) {
    const unsigned G = gridDim.x * gridDim.y * gridDim.z;
    unsigned sum, cnt, mine, sp = 0u;
    for (;;) {
        sum = 0u; cnt = 0u; mine = 0u;
#pragma unroll
        for (unsigned j = 0; j < 16; ++j) { const unsigned c = xb_ld(&bar[XB_XCNT(j)]); sum += c; cnt += (c > 0u) ? 1u : 0u; mine = (j == x) ? c : mine; }
        if (sum == G) break;
        __builtin_amdgcn_s_sleep(1);
        if ((++sp & 255u) == 0u) { if (xb_ld(&bar[XB_TMO])) break; if (sp > XB_SPIN_CAP) { atomicAdd(&bar[XB_TMO], 1u); break; } }
    }
    nloc = mine > 0u ? mine : 1u; nx = cnt > 0u ? cnt : 1u;
}
__device__ __forceinline__ void xcd_barrier(const XcdBarrier& b) {
    asm volatile("s_waitcnt vmcnt(0)" ::: "memory");
    __syncthreads();
    if (threadIdx.x == 0) {
        unsigned* bar = b.bar;
        __builtin_amdgcn_s_waitcnt(0);
        unsigned nloc = b.st[0], nx = b.st[1];
        if (nloc == 0u) { xcd_barrier_complete(bar, b.x, nloc, nx); b.st[0] = nloc; b.st[1] = nx; }
        const unsigned old = xb_add(&bar[XB_XSUB(b.x)], 1u);
        const unsigned gen = old / nloc;
        if (old + 1u == (gen + 1u) * nloc) {
            __builtin_amdgcn_fence(__ATOMIC_RELEASE, "agent");
            asm volatile("s_waitcnt vmcnt(0)" ::: "memory");
            const unsigned og = xb_add(&bar[XB_TOP], 1u);
            const unsigned tg = og / nx;
            if (og + 1u == (tg + 1u) * nx) xb_add(&bar[XB_TOPGEN], 1u);
            else XB_SPIN(xb_ld(&bar[XB_TOPGEN]) == tg, bar);
            __builtin_amdgcn_fence(__ATOMIC_ACQUIRE, "agent");
            xb_add(&bar[XB_XGEN(b.x)], 1u);
            asm volatile("s_waitcnt vmcnt(0)" ::: "memory");
        } else {
            XB_SPIN(xb_ld(&bar[XB_XGEN(b.x)]) == gen, bar);
            __builtin_amdgcn_fence(__ATOMIC_ACQUIRE, "agent");
            asm volatile("s_waitcnt vmcnt(0)" ::: "memory");
        }
    }
    __syncthreads();
}

struct Frame {
    LAS unsigned char* lds;
    int tid, lane, wave, G, bid;
    float* XR; unsigned char* ws;
};
constexpr size_t WS_DBG = 60 * 1024;
__device__ __forceinline__ void dbg_add(Frame& F, float v) { atomicAdd((float*)(F.ws + WS_DBG), v); }
template <int K> __device__ __forceinline__ const float* inp() {
    unsigned long long v; const unsigned long long kp = (unsigned long long)__builtin_amdgcn_kernarg_segment_ptr();
    asm volatile("s_load_dwordx2 %0, %1, %2\n\ts_waitcnt lgkmcnt(0)" : "=s"(v) : "s"(kp), "n"(K * 8));
    return (const float*)v;
}
enum { I_X = 0, I_C, I_REL, I_W_IN_E, I_W_OUT_E, I_SINKS, I_W_IN_O, I_W_OUT_O, I_F_W1, I_F_W3, I_F_W2, I_ROUTER, I_E_W1, I_E_W3, I_E_W2, I_ADA_W, I_ADA_B, I_LN_G, I_LN_B };
__device__ __forceinline__ float sum32(float v) { const auto r = __builtin_amdgcn_permlane32_swap(__builtin_bit_cast(unsigned, v), __builtin_bit_cast(unsigned, v), false, false); const unsigned a = r[0], b = r[1]; return __builtin_bit_cast(float, a) + __builtin_bit_cast(float, b); }
__device__ __forceinline__ float max32(float v) { const auto r = __builtin_amdgcn_permlane32_swap(__builtin_bit_cast(unsigned, v), __builtin_bit_cast(unsigned, v), false, false); const unsigned a = r[0], b = r[1]; return fmaxf(__builtin_bit_cast(float, a), __builtin_bit_cast(float, b)); }
__device__ __forceinline__ float sum16(float v) { const auto r = __builtin_amdgcn_permlane16_swap(__builtin_bit_cast(unsigned, v), __builtin_bit_cast(unsigned, v), false, false); const unsigned a = r[0], b = r[1]; return __builtin_bit_cast(float, a) + __builtin_bit_cast(float, b); }
__device__ __forceinline__ float max16(float v) { const auto r = __builtin_amdgcn_permlane16_swap(__builtin_bit_cast(unsigned, v), __builtin_bit_cast(unsigned, v), false, false); const unsigned a = r[0], b = r[1]; return fmaxf(__builtin_bit_cast(float, a), __builtin_bit_cast(float, b)); }
template <int CTRL> __device__ __forceinline__ float dpp_f(float v) { return __builtin_bit_cast(float, __builtin_amdgcn_update_dpp(0, __builtin_bit_cast(int, v), CTRL, 0xf, 0xf, true)); }
__device__ __forceinline__ float wave_sum(float v) {
    v += dpp_f<0xB1>(v);
    v += dpp_f<0x4E>(v);
    v += dpp_f<0x141>(v);
    v += dpp_f<0x140>(v);
    v = sum16(v); v = sum32(v);
    return v;
}
__device__ __forceinline__ float wave_max(float v) {
#pragma unroll
    for (int o = 1; o < 64; o <<= 1) v = fmaxf(v, __shfl_xor(v, o));
    return v;
}
__device__ __forceinline__ int crow(int r, int hi) { return (r & 3) + 8 * (r >> 2) + 4 * hi; }
__device__ __forceinline__ int t5_bucket(int n) {
    if (n < 16) return n < 0 ? 0 : n;
    int k = 0;
    k += n >= 22; k += n >= 30; k += n >= 40; k += n >= 54; k += n >= 73; k += n >= 99; k += n >= 134; k += n >= 182;
    k += n >= 246; k += n >= 332; k += n >= 450; k += n >= 609; k += n >= 825; k += n >= 1117; k += n >= 1513;
    return 16 + k;
}
__device__ __forceinline__ s16x4 vtr(LAS const unsigned char* p) { typedef short v4i16_t __attribute__((ext_vector_type(4))); return __builtin_bit_cast(s16x4, __builtin_amdgcn_ds_read_tr16_b64_v4i16((LAS v4i16_t*)p)); }

__device__ __forceinline__ void tr_item(const float* W, int K, int N, bf16* WT, int drow0, LAS float* scr, int k0, int n0, int lane) {
    const int col = n0 + 4 * (lane & 7);
    f32x4 ld[8];
#pragma unroll
    for (int i = 0; i < 8; ++i) { const int kk = 8 * i + (lane >> 3); ld[i] = col < N ? *(const f32x4*)(W + (size_t)(k0 + kk) * N + col) : (f32x4){0.f, 0.f, 0.f, 0.f}; }
#pragma unroll
    for (int i = 0; i < 8; ++i) { const int kk = 8 * i + (lane >> 3); LAS float* d = scr + kk * 33 + 4 * (lane & 7); d[0] = ld[i].x; d[1] = ld[i].y; d[2] = ld[i].z; d[3] = ld[i].w; }
    LDS_WAIT(); CBAR();
    const int c = lane & 7;
#pragma unroll
    for (int j = 0; j < 4; ++j) { const int n = (lane >> 3) + 8 * j; const LAS float* s = scr + (8 * c) * 33 + n;
        v4u o; o.x = pk2(s[0 * 33], s[1 * 33]); o.y = pk2(s[2 * 33], s[3 * 33]); o.z = pk2(s[4 * 33], s[5 * 33]); o.w = pk2(s[6 * 33], s[7 * 33]);
        *(GAS v4u*)(WT + (size_t)(drow0 + n) * K + k0 + 8 * c) = o; }
    LDS_WAIT(); CBAR();
}
__device__ __forceinline__ void tr_item8(const float* W, int K, int N, unsigned char* WT, int drow0, LAS float* scr, int k0, int n0, int lane, float wsc) {
    const int col = n0 + 4 * (lane & 7);
    f32x4 ld[8];
#pragma unroll
    for (int i = 0; i < 8; ++i) { const int kk = 8 * i + (lane >> 3); ld[i] = col < N ? *(const f32x4*)(W + (size_t)(k0 + kk) * N + col) : (f32x4){0.f, 0.f, 0.f, 0.f}; }
#pragma unroll
    for (int i = 0; i < 8; ++i) { const int kk = 8 * i + (lane >> 3); LAS float* d = scr + kk * 33 + 4 * (lane & 7); d[0] = ld[i].x * wsc; d[1] = ld[i].y * wsc; d[2] = ld[i].z * wsc; d[3] = ld[i].w * wsc; }
    LDS_WAIT(); CBAR();
    const int c = lane & 3;
#pragma unroll
    for (int j = 0; j < 2; ++j) { const int n = (lane >> 2) + 16 * j; const LAS float* s = scr + (16 * c) * 33 + n;
        v4u o; o.x = pk4_fp8(s[0 * 33], s[1 * 33], s[2 * 33], s[3 * 33]); o.y = pk4_fp8(s[4 * 33], s[5 * 33], s[6 * 33], s[7 * 33]);
        o.z = pk4_fp8(s[8 * 33], s[9 * 33], s[10 * 33], s[11 * 33]); o.w = pk4_fp8(s[12 * 33], s[13 * 33], s[14 * 33], s[15 * 33]);
        *(GAS v4u*)(WT + (size_t)(drow0 + n) * K + k0 + 16 * c) = o; }
    LDS_WAIT(); CBAR();
}
__device__ __forceinline__ void conv_small(Frame& F) {
    LAS float* scr = (LAS float*)(F.lds + F.wave * 16384);
    const int gw = F.bid * NWAVES + F.wave, NGW = F.G * NWAVES;
    constexpr int I_IE = 16 * 72, I_O = 16 * 32, I_IO = 16 * 56, PER = I_IE + I_O + I_IO + I_O;
    for (int it = gw; it < 2 * PER; it += NGW) {
        const int i = it / PER; int r = it % PER;
        if (r < I_IE) { if (PROJ_FP8) tr_item8(inp<I_W_IN_E>() + (size_t)i * D * EV_IN, D, EV_IN, (unsigned char*)(F.ws + WS_WINE) + (size_t)i * EV_IN * D, 32 * (r % 72), scr, 64 * (r / 72), 32 * (r % 72), F.lane, 32.f); else tr_item(inp<I_W_IN_E>() + (size_t)i * D * EV_IN, D, EV_IN, (bf16*)(F.ws + WS_WINE) + (size_t)i * EV_IN * D, 32 * (r % 72), scr, 64 * (r / 72), 32 * (r % 72), F.lane); continue; } r -= I_IE;
        if (r < I_O) { if (PROJ_FP8) tr_item8(inp<I_W_OUT_E>() + (size_t)i * D * D, D, D, (unsigned char*)(F.ws + WS_WOE) + (size_t)i * D * D, 32 * (r % 32), scr, 64 * (r / 32), 32 * (r % 32), F.lane, 64.f); else tr_item(inp<I_W_OUT_E>() + (size_t)i * D * D, D, D, (bf16*)(F.ws + WS_WOE) + (size_t)i * D * D, 32 * (r % 32), scr, 64 * (r / 32), 32 * (r % 32), F.lane); continue; } r -= I_O;
        if (r < I_IO) { tr_item(inp<I_W_IN_O>() + (size_t)i * D * OD_IN, D, OD_IN, (bf16*)(F.ws + WS_WINO) + (size_t)i * OD_INP * D, 32 * (r % 56), scr, 64 * (r / 56), 32 * (r % 56), F.lane); continue; } r -= I_IO;
        if (PROJ_FP8) tr_item8(inp<I_W_OUT_O>() + (size_t)i * D * D, D, D, (unsigned char*)(F.ws + WS_WOO) + (size_t)i * D * D, 32 * (r % 32), scr, 64 * (r / 32), 32 * (r % 32), F.lane, 64.f);
        else tr_item(inp<I_W_OUT_O>() + (size_t)i * D * D, D, D, (bf16*)(F.ws + WS_WOO) + (size_t)i * D * D, 32 * (r % 32), scr, 64 * (r / 32), 32 * (r % 32), F.lane);
    }
}
__device__ __forceinline__ void conv_ffn(Frame& F, int layer) {
    LAS float* scr = (LAS float*)(F.lds + F.wave * 16384);
    const int gw = F.bid * NWAVES + F.wave, NGW = F.G * NWAVES;
    const int i = layer >> 1; const bool odd = layer & 1; const int ne = odd ? NE : 1;
    const size_t lo_ = odd ? (size_t)i * NE * D * FF : (size_t)i * D * FF;
    constexpr int I13 = 16 * 112, I2 = 56 * 32, PER = 2 * I13 + I2;
    for (int it = gw; it < ne * PER; it += NGW) {
        const int e = it / PER; int r = it % PER;
        bf16* d13 = (bf16*)(F.ws + WS_W13) + (size_t)e * 2 * FF * D; bf16* d2 = (bf16*)(F.ws + WS_W2) + (size_t)e * D * FF;
        if (r < 2 * I13) { const int half = r / I13; r %= I13; const int n0 = 32 * (r % 112), k0 = 64 * (r / 112);
            const float* wsrc = (half ? (odd ? inp<I_E_W3>() : inp<I_F_W3>()) : (odd ? inp<I_E_W1>() : inp<I_F_W1>())) + lo_ + (size_t)e * D * FF;
            if (odd ? UP_FP8_MOE : UP_FP8_DENSE) tr_item8(wsrc, D, FF, (unsigned char*)(F.ws + WS_W13) + (size_t)e * 2 * FF * D, 256 * (n0 >> 7) + 128 * half + (n0 & 127), scr, k0, n0, F.lane, 32.f);
            else tr_item(wsrc, D, FF, d13, 256 * (n0 >> 7) + 128 * half + (n0 & 127), scr, k0, n0, F.lane);
            continue; }
        r -= 2 * I13;
        if (odd ? DOWN_FP8_MOE : DOWN_FP8_DENSE) tr_item8((odd ? inp<I_E_W2>() : inp<I_F_W2>()) + lo_ + (size_t)e * FF * D, FF, D, (unsigned char*)(F.ws + WS_W2) + (size_t)e * D * FF, 32 * (r % 32), scr, 64 * (r / 32), 32 * (r % 32), F.lane, 128.f);
        else tr_item((odd ? inp<I_E_W2>() : inp<I_F_W2>()) + lo_ + (size_t)e * FF * D, FF, D, d2, 32 * (r % 32), scr, 64 * (r / 32), 32 * (r % 32), F.lane);
    }
}
__device__ __forceinline__ void mod_phase(Frame& F) {
    LAS float* sc = (LAS float*)(F.lds);
    LAS float* part = (LAS float*)(F.lds + 16384);
    __syncthreads();
    { const float* cp_ = inp<I_C>(); for (int u = F.tid; u < NB * D; u += 512) { const float v = cp_[u]; sc[u] = v / (1.f + __expf(-v)); } }
    __syncthreads();
    const int kc = F.tid >> 6, col = F.tid & 63;
    for (int it = F.bid; it < 8 * 48; it += F.G) {
        const int ls = it / 48, cb = it % 48;
        const float* w = inp<I_ADA_W>() + (size_t)ls * D * 3 * D + cb * 64 + col;
        float a0 = 0.f, a1 = 0.f, a2 = 0.f, a3 = 0.f;
#pragma unroll 8
        for (int k = kc * 128; k < kc * 128 + 128; ++k) { const float wv = w[(size_t)k * 3 * D]; a0 += sc[k] * wv; a1 += sc[1024 + k] * wv; a2 += sc[2048 + k] * wv; a3 += sc[3072 + k] * wv; }
        part[(kc * 4 + 0) * 64 + col] = a0; part[(kc * 4 + 1) * 64 + col] = a1; part[(kc * 4 + 2) * 64 + col] = a2; part[(kc * 4 + 3) * 64 + col] = a3;
        __syncthreads();
        if (F.tid < 256) { const int b = F.tid >> 6; float s = 0.f;
#pragma unroll
            for (int k2 = 0; k2 < 8; ++k2) s += part[(k2 * 4 + b) * 64 + col];
            const int n3 = cb * 64 + col, j = n3 >> 10, n = n3 & 1023;
            s += inp<I_ADA_B>()[ls * 3 * D + n3] + (j ? 1.f : 0.f);
            ((float*)(F.ws + WS_MOD))[((ls * 3 + j) * NB + b) * D + n] = s; }
        __syncthreads();
    }
}
__device__ __forceinline__ const float* mod_ptr(Frame& F, int ls, int j, int b) { return (const float*)(F.ws + WS_MOD) + ((ls * 3 + j) * NB + b) * D; }

__device__ __forceinline__ void h0_phase(Frame& F) {
    const int row0 = F.bid * 128 + F.wave * 16, b = row0 >> 13;
    const float* sh = mod_ptr(F, 0, 0, b); const float* sc = mod_ptr(F, 0, 1, b);
    f32x4 shv[4], scv[4];
#pragma unroll
    for (int j = 0; j < 4; ++j) { shv[j] = *(const f32x4*)(sh + 4 * F.lane + 256 * j); scv[j] = *(const f32x4*)(sc + 4 * F.lane + 256 * j); }
    const float* xp_ = inp<I_X>();
    for (int i = 0; i < 16; ++i) { const int row = row0 + i;
        const f32x4* xr = (const f32x4*)(xp_ + (size_t)row * D) + F.lane; unsigned long long* o8 = (unsigned long long*)((bf16*)(F.ws + WS_H) + (size_t)row * D) + F.lane;
#pragma unroll
        for (int j = 0; j < 4; ++j) { const f32x4 v = xr[64 * j] * scv[j] + shv[j]; if (PROJ_FP8) ((unsigned*)(F.ws + WS_H + (size_t)row * D) + F.lane)[64 * j] = pk4_fp8(v.x, v.y, v.z, v.w); else o8[64 * j] = (unsigned long long)pk2(v.x, v.y) | ((unsigned long long)pk2(v.z, v.w) << 32); } }
}

template <int MODE>
__device__ __forceinline__ void ln_phase(Frame& F, int layer, int sub, bool last) {
    const int row0 = F.bid * 128 + F.wave * 16, b = row0 >> 13;
    const int ls = layer * 2 + sub, lsn = ls + 1;
    LAS float* wrt = (LAS float*)(F.lds);
    LAS int* cw = (LAS int*)(F.lds + 32768);
    if (MODE == 1) {
        __syncthreads();
        const float* wr = inp<I_ROUTER>() + (size_t)(layer >> 1) * D * NE;
        for (int u = F.tid; u < D * NE; u += 512) wrt[(u & 7) * 1024 + (u >> 3)] = wr[u];
        __syncthreads();
    }
    f32x4 gv[4], bv[4], shv[4], scv[4], gav[4];
    { const float* g = inp<I_LN_G>() + ls * D; const float* bb = inp<I_LN_B>() + ls * D;
#pragma unroll
      for (int j = 0; j < 4; ++j) { gv[j] = *(const f32x4*)(g + 4 * F.lane + 256 * j); bv[j] = *(const f32x4*)(bb + 4 * F.lane + 256 * j); } }
    if (!last) { const float* sh = mod_ptr(F, lsn, 0, b); const float* sc = mod_ptr(F, lsn, 1, b);
#pragma unroll
      for (int j = 0; j < 4; ++j) { shv[j] = *(const f32x4*)(sh + 4 * F.lane + 256 * j); scv[j] = *(const f32x4*)(sc + 4 * F.lane + 256 * j); } }
    if (MODE == 2) { const float* ga = mod_ptr(F, ls, 2, b);
#pragma unroll
      for (int j = 0; j < 4; ++j) gav[j] = *(const f32x4*)(ga + 4 * F.lane + 256 * j); }
    float dbgv = 0.f; if (PROBE_DBG && last) dbgv = __hip_atomic_load((float*)(F.ws + WS_DBG), __ATOMIC_RELAXED, __HIP_MEMORY_SCOPE_AGENT);
    unsigned long long cnt64 = 0ull;
    constexpr int RB = (MODE == 2) ? 2 : 4;
    for (int i0 = 0; i0 < 16; i0 += RB) {
      v2u xin[RB][4], rtv[RB], rgv[RB], ya[RB][4], yc[RB][4];
#pragma unroll
      for (int r = 0; r < RB; ++r) { const v2u* xp = (const v2u*)((const bf16*)(F.ws + WS_XH) + (size_t)(row0 + i0 + r) * D) + F.lane;
#pragma unroll
          for (int j = 0; j < 4; ++j) xin[r][j] = xp[64 * j];
          if (MODE == 2) { rtv[r] = *(const v2u*)(F.ws + WS_RT_S + (size_t)(row0 + i0 + r) * 8); rgv[r] = *(const v2u*)(F.ws + WS_RT_G + (size_t)(row0 + i0 + r) * 8); } }
      if (MODE == 2) {
#pragma unroll
          for (int r = 0; r < RB; ++r) { const unsigned s1 = rtv[r].x, s2 = rtv[r].y;
              const v2u* y1 = (const v2u*)((const bf16*)(F.ws + WS_XB) + (size_t)s1 * D) + F.lane; const v2u* y2 = (const v2u*)((const bf16*)(F.ws + WS_XB) + (size_t)s2 * D) + F.lane;
#pragma unroll
              for (int j = 0; j < 4; ++j) { ya[r][j] = y1[64 * j]; yc[r][j] = y2[64 * j]; } } }
#pragma unroll
      for (int r = 0; r < RB; ++r) { const int i = i0 + r; const int row = row0 + i;
        v2u* xr = (v2u*)((bf16*)(F.ws + WS_XH) + (size_t)row * D) + F.lane;
        f32x4 v[4]; float s = 0.f;
#pragma unroll
        for (int j = 0; j < 4; ++j) { const v2u a = xin[r][j]; v[j] = (f32x4){bflo(a.x), bfhi(a.x), bflo(a.y), bfhi(a.y)}; }
        if (MODE == 2) {
            const unsigned g1u = rgv[r].x, g2u = rgv[r].y; const float g1 = __uint_as_float(g1u), g2 = __uint_as_float(g2u);
#pragma unroll
            for (int j = 0; j < 4; ++j) { const v2u a = ya[r][j], c = yc[r][j];
                f32x4 ff; ff.x = g1 * bflo(a.x) + g2 * bflo(c.x); ff.y = g1 * bfhi(a.x) + g2 * bfhi(c.x); ff.z = g1 * bflo(a.y) + g2 * bflo(c.y); ff.w = g1 * bfhi(a.y) + g2 * bfhi(c.y);
                v[j] = v[j] * ALPHA + gav[j] * ff * AM_M; }
        }
#pragma unroll
        for (int j = 0; j < 4; ++j) s += (v[j].x + v[j].y) + (v[j].z + v[j].w);
        const float mean = wave_sum(s) * (1.f / D); float s2 = 0.f;
#pragma unroll
        for (int j = 0; j < 4; ++j) { v[j] = v[j] - mean; s2 += (v[j].x * v[j].x + v[j].y * v[j].y) + (v[j].z * v[j].z + v[j].w * v[j].w); }
        const float rstd = 1.f / sqrtf(wave_sum(s2) * (1.f / D) + LN_EPS);
#pragma unroll
        for (int j = 0; j < 4; ++j) { v[j] = v[j] * rstd * gv[j] + bv[j]; if (PROBE_DBG && last) v[j] = v[j] * (1.f + dbgv);
            if (last) ((f32x4*)((float*)inp<19>() + (size_t)row * D) + F.lane)[64 * j] = v[j];
            else { v2u w; w.x = pk2(v[j].x, v[j].y); w.y = pk2(v[j].z, v[j].w); xr[64 * j] = w; } }
        if (!last) {
            if ((sub == 0 && ((layer & 1) ? UP_FP8_MOE : UP_FP8_DENSE)) || (sub == 1 && (layer & 1) && PROJ_FP8)) {
                unsigned* o4 = (unsigned*)(F.ws + WS_H + (size_t)row * D) + F.lane;
#pragma unroll
                for (int j = 0; j < 4; ++j) { v[j] = v[j] * scv[j] + shv[j]; o4[64 * j] = pk4_fp8(v[j].x, v[j].y, v[j].z, v[j].w); }
            } else {
                unsigned long long* o8 = (unsigned long long*)((bf16*)(F.ws + WS_H) + (size_t)row * D) + F.lane;
#pragma unroll
                for (int j = 0; j < 4; ++j) { v[j] = v[j] * scv[j] + shv[j]; o8[64 * j] = (unsigned long long)pk2(v[j].x, v[j].y) | ((unsigned long long)pk2(v[j].z, v[j].w) << 32); }
            }
        }
        if (MODE == 1) {
            float lg[8];
#pragma unroll
            for (int e = 0; e < 8; ++e) { float a = 0.f;
#pragma unroll
                for (int j = 0; j < 4; ++j) { const f32x4 w = *(const LAS f32x4*)(wrt + e * 1024 + 256 * j + 4 * F.lane); a += (v[j].x * w.x + v[j].y * w.y) + (v[j].z * w.z + v[j].w * w.w); }
                lg[e] = a; __builtin_amdgcn_sched_barrier(0); }
            {
                const bool h5 = F.lane & 32, h4 = F.lane & 16, h3 = F.lane & 8;
                float a4[4], a2[2], a1;
#pragma unroll
                for (int k = 0; k < 4; ++k) { const float keep = h5 ? lg[4 + k] : lg[k], send = h5 ? lg[k] : lg[4 + k]; a4[k] = keep + __shfl_xor(send, 32); }
#pragma unroll
                for (int k = 0; k < 2; ++k) { const float keep = h4 ? a4[2 + k] : a4[k], send = h4 ? a4[k] : a4[2 + k]; a2[k] = keep + __shfl_xor(send, 16); }
                { const float keep = h3 ? a2[1] : a2[0], send = h3 ? a2[0] : a2[1]; a1 = keep + __shfl_xor(send, 8); }
                a1 += dpp_f<0xB1>(a1); a1 += dpp_f<0x4E>(a1); a1 += dpp_f<0x141>(a1);
#pragma unroll
                for (int e = 0; e < 8; ++e) lg[e] = __builtin_bit_cast(float, __builtin_amdgcn_readlane(__builtin_bit_cast(int, a1), ((e >> 2) & 1) * 32 + ((e >> 1) & 1) * 16 + (e & 1) * 8)); }
            int i1 = 0; float v1 = lg[0];
#pragma unroll
            for (int e = 1; e < 8; ++e) if (lg[e] > v1) { v1 = lg[e]; i1 = e; }
            int i2 = -1; float v2 = -3.0e38f;
#pragma unroll
            for (int e = 0; e < 8; ++e) if (e != i1 && lg[e] > v2) { v2 = lg[e]; i2 = e; }
            i1 = __builtin_amdgcn_readfirstlane(i1); i2 = __builtin_amdgcn_readfirstlane(i2);
            const float p2 = 1.f / (1.f + __expf(v1 - v2)), p1 = 1.f - p2;
            const unsigned r1 = (unsigned)(cnt64 >> (6 * i1)) & 63u; cnt64 += 1ull << (6 * i1);
            const unsigned r2 = (unsigned)(cnt64 >> (6 * i2)) & 63u; cnt64 += 1ull << (6 * i2);
            if (PROBE_DBG == 12 && layer == 1 && F.lane == 0) dbg_add(F, p1 * (1.f / (float)T));
            if (PROBE_DBG == 13 && layer == 1 && F.lane == 0) dbg_add(F, fabsf(v1) * (1.f / (float)T));
            if (F.lane == 0) { v2u re; re.x = (unsigned)i1 | (r1 << 8); re.y = (unsigned)i2 | (r2 << 8); v2u rg; rg.x = __builtin_bit_cast(unsigned, p1); rg.y = __builtin_bit_cast(unsigned, p2);
                *(v2u*)(F.ws + WS_RT_E + (size_t)row * 8) = re; *(v2u*)(F.ws + WS_RT_G + (size_t)row * 8) = rg; }
        }
      }
    }
    if (MODE == 1) {
        if (F.lane < 8) { const int cval = (int)((cnt64 >> (6 * F.lane)) & 63ull); cw[F.wave * 8 + F.lane] = cval; ((int*)(F.ws + WS_CNTW))[(F.bid * 8 + F.wave) * 8 + F.lane] = cval; }
        __syncthreads();
        if (F.tid < 8) { int s = 0;
#pragma unroll
            for (int w = 0; w < 8; ++w) s += cw[w * 8 + F.tid];
            ((int*)(F.ws + WS_CNTG))[F.bid * 8 + F.tid] = s; }
        __syncthreads();
    }
}
#define US ((const LAS int*)(F.lds + RING_BYTES + 512))
#define PRE ((const LAS int*)(F.lds + RING_BYTES + 576))
__device__ __forceinline__ void dense_units(Frame& F) {
    __syncthreads();
    if (F.tid < 9) ((LAS int*)(F.lds + RING_BYTES + 512))[F.tid] = F.tid ? T / 256 : 0;
    __syncthreads();
}
__device__ __forceinline__ void moe_units(Frame& F) {
    LAS int* acc = (LAS int*)(F.lds + RING_BYTES + 640);
    __syncthreads();
    if (F.tid < 16) acc[F.tid] = 0;
    __syncthreads();
    if (F.tid < 256) { const int* cg = (const int*)(F.ws + WS_CNTG) + F.tid * 8;
#pragma unroll
        for (int e = 0; e < 8; ++e) { const int v = cg[e]; __hip_atomic_fetch_add(acc + e, v, __ATOMIC_RELAXED, __HIP_MEMORY_SCOPE_WORKGROUP); if (F.tid < F.bid) __hip_atomic_fetch_add(acc + 8 + e, v, __ATOMIC_RELAXED, __HIP_MEMORY_SCOPE_WORKGROUP); } }
    __syncthreads();
    if (F.tid == 0) { int u0 = 0; LAS int* us = (LAS int*)(F.lds + RING_BYTES + 512); LAS int* pre = (LAS int*)(F.lds + RING_BYTES + 576);
        for (int e = 0; e < 8; ++e) { us[e] = u0; u0 += (acc[e] + 255) >> 8; pre[e] = acc[8 + e]; }
        us[8] = u0; }
    __syncthreads();
}
__device__ __forceinline__ void gather_phase(Frame& F, int layer) {
    moe_units(F);
    if (PROBE_DBG == 4 && layer == 1 && F.bid == 0 && F.tid == 0) dbg_add(F, (float)(US[8] - 256) * 0.125f);
    if (PROBE_DBG == 5 && layer == 1 && F.bid == 255 && F.tid == 0) dbg_add(F, (float)PRE[0] * (1.f / 8192.f));
    int wp[8];
#pragma unroll
    for (int e = 0; e < 8; ++e) { int s = 0; for (int w = 0; w < F.wave; ++w) s += ((const int*)(F.ws + WS_CNTW))[(F.bid * 8 + w) * 8 + e]; wp[e] = US[e] * 256 + PRE[e] + s; }
    const int row0 = F.bid * 128 + F.wave * 16;
    for (int i = 0; i < 16; ++i) { const int row = row0 + i;
        v2u rt = *(const v2u*)(F.ws + WS_RT_E + (size_t)row * 8);
        const int e1 = rt.x & 255, r1 = rt.x >> 8, e2 = rt.y & 255, r2 = rt.y >> 8;
        int b1 = 0, b2 = 0;
#pragma unroll
        for (int e = 0; e < 8; ++e) { b1 = (e == e1) ? wp[e] : b1; b2 = (e == e2) ? wp[e] : b2; }
        const int s1 = b1 + r1, s2 = b2 + r2;
        if (UP_FP8_MOE) {
            const v4u a = ((const v4u*)(F.ws + WS_H + (size_t)row * D))[F.lane];
            ((v4u*)(F.ws + WS_XB + (size_t)s1 * D))[F.lane] = a; ((v4u*)(F.ws + WS_XB + (size_t)s2 * D))[F.lane] = a;
        } else {
        const v4u* src = (const v4u*)((const bf16*)(F.ws + WS_H) + (size_t)row * D) + F.lane;
        v4u* d1 = (v4u*)((bf16*)(F.ws + WS_XB) + (size_t)s1 * D) + F.lane; v4u* d2 = (v4u*)((bf16*)(F.ws + WS_XB) + (size_t)s2 * D) + F.lane;
        const v4u a = src[0], c = src[64]; d1[0] = a; d1[64] = c; d2[0] = a; d2[64] = c;
        }
        if (PROBE_DBG == 6 && layer == 1 && F.lane == 0) dbg_add(F, (float)s1 * (1.f / ((float)T * 32768.f)));
        if (F.lane == 0) { v2u rs; rs.x = (unsigned)s1; rs.y = (unsigned)s2; *(v2u*)(F.ws + WS_RT_S + (size_t)row * 8) = rs; }
    }
}

__device__ __forceinline__ void combine_item(Frame& F, int row, int c8) { const int h = c8 >> 3;
        const float* lse = (const float*)(F.ws + WS_LSE);
        const float l0 = lse[((size_t)0 * T + row) * 8 + h], l1 = lse[((size_t)1 * T + row) * 8 + h], l2 = lse[((size_t)2 * T + row) * 8 + h];
        const float mx = fmaxf(l0, fmaxf(l1, l2)); float w0 = __builtin_amdgcn_exp2f(l0 - mx), w1 = __builtin_amdgcn_exp2f(l1 - mx), w2 = __builtin_amdgcn_exp2f(l2 - mx);
        const float inv = 1.f / (w0 + w1 + w2); w0 *= inv; w1 *= inv; w2 *= inv;
        const bf16* P = (const bf16*)(F.ws + WS_PART);
        const v4u a = *(const v4u*)(P + ((size_t)0 * T + row) * 512 + c8 * 8), c = *(const v4u*)(P + ((size_t)1 * T + row) * 512 + c8 * 8), d = *(const v4u*)(P + ((size_t)2 * T + row) * 512 + c8 * 8);
        if (PROJ_FP8) { v2u o8;
            o8.x = pk4_fp8(w0 * bflo(a.x) + w1 * bflo(c.x) + w2 * bflo(d.x), w0 * bfhi(a.x) + w1 * bfhi(c.x) + w2 * bfhi(d.x), w0 * bflo(a.y) + w1 * bflo(c.y) + w2 * bflo(d.y), w0 * bfhi(a.y) + w1 * bfhi(c.y) + w2 * bfhi(d.y));
            o8.y = pk4_fp8(w0 * bflo(a.z) + w1 * bflo(c.z) + w2 * bflo(d.z), w0 * bfhi(a.z) + w1 * bfhi(c.z) + w2 * bfhi(d.z), w0 * bflo(a.w) + w1 * bflo(c.w) + w2 * bflo(d.w), w0 * bfhi(a.w) + w1 * bfhi(c.w) + w2 * bfhi(d.w));
            *(v2u*)((unsigned char*)(F.ws + WS_O) + (size_t)row * D + c8 * 8) = o8; return; }
        v4u o;
        o.x = pk2(w0 * bflo(a.x) + w1 * bflo(c.x) + w2 * bflo(d.x), w0 * bfhi(a.x) + w1 * bfhi(c.x) + w2 * bfhi(d.x));
        o.y = pk2(w0 * bflo(a.y) + w1 * bflo(c.y) + w2 * bflo(d.y), w0 * bfhi(a.y) + w1 * bfhi(c.y) + w2 * bfhi(d.y));
        o.z = pk2(w0 * bflo(a.z) + w1 * bflo(c.z) + w2 * bflo(d.z), w0 * bfhi(a.z) + w1 * bfhi(c.z) + w2 * bfhi(d.z));
        o.w = pk2(w0 * bflo(a.w) + w1 * bflo(c.w) + w2 * bflo(d.w), w0 * bfhi(a.w) + w1 * bfhi(c.w) + w2 * bfhi(d.w));
        *(v4u*)((bf16*)(F.ws + WS_O) + (size_t)row * D + c8 * 8) = o; }
__device__ __forceinline__ void band_phase(Frame& F, int li) {
    LAS float* btab = (LAS float*)(F.lds);
    LAS unsigned char* vbuf = F.lds + 32768 + F.wave * 4096;
    __syncthreads();
    const float* relp_ = inp<I_REL>();
    for (int u = F.tid; u < 4 * 8 * 129; u += 512) { const int cfg = u / (8 * 129), r = u % (8 * 129), h = r / 129, dist = r % 129;
        const int dil = cfg == 1 ? 4 : (cfg == 2 ? 16 : 1);
        btab[(cfg * 8 + h) * 132 + dist] = relp_[t5_bucket(dil * dist) * 16 + (cfg == 3 ? 8 + h : h)] * LOG2E; }
    __syncthreads();
    const bf16* QKV = (const bf16*)(F.ws + WS_QKV);
    const int lane = F.lane, n = lane & 31, hi = lane >> 5;
    const int gw = F.bid * NWAVES + F.wave, NGW = F.G * NWAVES;
    for (int wu = F.bid; wu < NB * 16 * 8; wu += F.G) {
      const int hq = wu & 7, blk = (wu >> 3) & 15, b = wu >> 7;
      for (int qi_ = F.wave; qi_ < 64; qi_ += NWAVES) {
        const int cfg = qi_ >> 4, sub = qi_ & 15;
        const int dsh = cfg == 1 ? 2 : (cfg == 2 ? 4 : 0), dil = 1 << dsh;
        const int r = cfg == 1 ? (sub >> 2) : (cfg == 2 ? sub : 0), tile = cfg == 1 ? (4 * blk + (sub & 3)) : (cfg == 2 ? blk : 16 * blk + sub), i0 = tile * 32;
        const int qoff = cfg == 3 ? 1536 : 0, koff = cfg == 3 ? 2048 : 512, voff = cfg == 3 ? 2176 : 1024, hk = cfg == 3 ? (hq >> 2) : hq, W = cfg == 3 ? 127 : 128;
        const size_t rowbase = (size_t)b * SEQ + r;
        const LAS float* bt = btab + (cfg * 8 + hq) * 132;
        bf16x8 qf[4];
        { const bf16* qrow = QKV + (rowbase + (size_t)(i0 + n) * dil) * EV_IN + qoff + hq * 64 + 8 * hi;
#pragma unroll
          for (int s = 0; s < 4; ++s) qf[s] = *(const bf16x8*)(qrow + 16 * s); }
        float m = NEGF, l = 0.f; f32x16 o0, o1;
#pragma unroll
        for (int i = 0; i < 16; ++i) { o0[i] = 0.f; o1[i] = 0.f; }
        const int jlo = (4 - tile) > 0 ? (4 - tile) : 0;
        bf16x8 kf[4], kn[4]; v4u vv[4], vn[4];
        { const int kj0 = i0;
          const bf16* krow = QKV + (rowbase + (size_t)(kj0 + n) * dil) * EV_IN + koff + hk * 64 + 8 * hi;
#pragma unroll
          for (int s = 0; s < 4; ++s) kf[s] = *(const bf16x8*)(krow + 16 * s);
#pragma unroll
          for (int i = 0; i < 4; ++i) { const int c = lane + 64 * i, key = c >> 3, ch = c & 7;
              vv[i] = *(const v4u*)(QKV + (rowbase + (size_t)(kj0 + key) * dil) * EV_IN + voff + hk * 64 + ch * 8); } }
        for (int j = 4; j >= jlo; --j) {
            if (j > jlo) { const int kj1 = i0 - 128 + 32 * (j - 1);
                const bf16* krow = QKV + (rowbase + (size_t)(kj1 + n) * dil) * EV_IN + koff + hk * 64 + 8 * hi;
#pragma unroll
                for (int s = 0; s < 4; ++s) kn[s] = *(const bf16x8*)(krow + 16 * s);
#pragma unroll
                for (int i = 0; i < 4; ++i) { const int c = lane + 64 * i, key = c >> 3, ch = c & 7;
                    vn[i] = *(const v4u*)(QKV + (rowbase + (size_t)(kj1 + key) * dil) * EV_IN + voff + hk * 64 + ch * 8); } }
            CBAR();
#pragma unroll
            for (int i = 0; i < 4; ++i) { const int c = lane + 64 * i, key = c >> 3, ch = c & 7;
                *(LAS v4u*)(vbuf + (ch >> 2) * 2048 + key * 64 + (ch & 3) * 16) = vv[i]; }
            f32x16 s;
#pragma unroll
            for (int i = 0; i < 16; ++i) s[i] = 0.f;
#pragma unroll
            for (int k = 0; k < 4; ++k) s = __builtin_amdgcn_mfma_f32_32x32x16_bf16(kf[k], qf[k], s, 0, 0, 0);
            const int dbase = 128 - 32 * j + n - 4 * hi;
            float mx = NEGF;
            if (j == 0 || j == 4) {
#pragma unroll
                for (int i = 0; i < 16; ++i) { const int dist = dbase - (i & 3) - 8 * (i >> 2); const bool ok = dist >= 0 && dist <= W;
                    const int di = dist < 0 ? 0 : (dist > 128 ? 128 : dist);
                    const float xv = s[i] * C2 + bt[di]; s[i] = ok ? xv : NEGF; mx = fmaxf(mx, s[i]); }
            } else {
                const LAS float* btd = bt + dbase;
#pragma unroll
                for (int i = 0; i < 16; ++i) { s[i] = s[i] * C2 + btd[-((i & 3) + 8 * (i >> 2))]; mx = fmaxf(mx, s[i]); }
            }
            mx = max32(mx);
            const float mnew = fmaxf(m, mx), alpha = __builtin_amdgcn_exp2f(m - mnew);
            float rs = 0.f;
#pragma unroll
            for (int i = 0; i < 16; ++i) { s[i] = __builtin_amdgcn_exp2f(s[i] - mnew); rs += s[i]; }
            rs = sum32(rs);
            l = l * alpha + rs; m = mnew;
#pragma unroll
            for (int i = 0; i < 16; ++i) { o0[i] *= alpha; o1[i] *= alpha; }
            bf16x8 pb[2];
#pragma unroll
            for (int ks = 0; ks < 2; ++ks) { v4u w; w.x = pk2(s[8 * ks + 0], s[8 * ks + 1]); w.y = pk2(s[8 * ks + 2], s[8 * ks + 3]); w.z = pk2(s[8 * ks + 4], s[8 * ks + 5]); w.w = pk2(s[8 * ks + 6], s[8 * ks + 7]);
                pb[ks] = __builtin_bit_cast(bf16x8, w); }
            CBAR();
            const int q4 = (lane & 15) >> 2, p4 = lane & 3, blk = (lane >> 4) & 1;
            const LAS unsigned char* vb = vbuf + (4 * hi + q4) * 64 + (16 * blk + 4 * p4) * 2;
#pragma unroll
            for (int dt = 0; dt < 2; ++dt)
#pragma unroll
                for (int ks = 0; ks < 2; ++ks) { const s16x4 lo = vtr(vb + dt * 2048 + (16 * ks) * 64), hh = vtr(vb + dt * 2048 + (16 * ks + 8) * 64);
                    const bf16x8 va = (bf16x8){lo[0], lo[1], lo[2], lo[3], hh[0], hh[1], hh[2], hh[3]};
                    if (dt == 0) o0 = __builtin_amdgcn_mfma_f32_32x32x16_bf16(va, pb[ks], o0, 0, 0, 0); else o1 = __builtin_amdgcn_mfma_f32_32x32x16_bf16(va, pb[ks], o1, 0, 0, 0); }
            CBAR();
            if (j > jlo) {
#pragma unroll
                for (int i = 0; i < 4; ++i) { kf[i] = kn[i]; vv[i] = vn[i]; } }
        }
        const size_t orow = rowbase + (size_t)(i0 + n) * dil;
        if (cfg == 3) l += __builtin_amdgcn_exp2f(inp<I_SINKS>()[li * 8 + hq] * LOG2E - m);
        const float inv = 1.f / l;
        bf16* op = cfg == 3 ? (bf16*)(F.ws + WS_O) + orow * D + 512 + hq * 64 : (bf16*)(F.ws + WS_PART) + ((size_t)cfg * T + orow) * 512 + hq * 64;
        if (PROJ_FP8 && cfg == 3) { unsigned char* o8p = (unsigned char*)(F.ws + WS_O) + orow * D + 512 + hq * 64;
#pragma unroll
            for (int g = 0; g < 4; ++g) { *(unsigned*)(o8p + 8 * g + 4 * hi) = pk4_fp8(o0[4 * g] * inv, o0[4 * g + 1] * inv, o0[4 * g + 2] * inv, o0[4 * g + 3] * inv);
                *(unsigned*)(o8p + 32 + 8 * g + 4 * hi) = pk4_fp8(o1[4 * g] * inv, o1[4 * g + 1] * inv, o1[4 * g + 2] * inv, o1[4 * g + 3] * inv); } }
        else
#pragma unroll
        for (int g = 0; g < 4; ++g) { v2u w0, w1; w0.x = pk2(o0[4 * g] * inv, o0[4 * g + 1] * inv); w0.y = pk2(o0[4 * g + 2] * inv, o0[4 * g + 3] * inv);
            w1.x = pk2(o1[4 * g] * inv, o1[4 * g + 1] * inv); w1.y = pk2(o1[4 * g + 2] * inv, o1[4 * g + 3] * inv);
            *(v2u*)(op + 8 * g + 4 * hi) = w0; *(v2u*)(op + 32 + 8 * g + 4 * hi) = w1; }
        if (cfg < 3 && hi == 0) ((float*)(F.ws + WS_LSE))[((size_t)cfg * T + orow) * 8 + hq] = m + __builtin_amdgcn_logf(l);
      }
      VM_WAIT(); __syncthreads(); __builtin_amdgcn_fence(__ATOMIC_ACQUIRE, "agent"); VM_WAIT();
      for (int ci = F.tid; ci < 512 * 8; ci += 512) { const int row = b * SEQ + blk * 512 + (ci >> 3), c8 = hq * 8 + (ci & 7); combine_item(F, row, c8); }
    }
}
__device__ __forceinline__ void find_bin(const LAS unsigned* hist, int K, int lane, int& bout, int& nabout) {
    const v4u c = *(const LAS v4u*)(hist + 4 * lane);
    const int s = (int)(c.x + c.y + c.z + c.w); int suf = s;
#pragma unroll
    for (int off = 1; off < 64; off <<= 1) { const int v = __shfl_down(suf, off); if (lane + off < 64) suf += v; }
    const unsigned long long mask = __ballot(suf >= K);
    const int Ls = mask ? 63 - __builtin_clzll(mask) : 0;
    int above = suf - s, bb;
    if (above + (int)c.w >= K) bb = 3; else { above += (int)c.w; if (above + (int)c.z >= K) bb = 2; else { above += (int)c.z; if (above + (int)c.y >= K) bb = 1; else { above += (int)c.y; bb = 0; } } }
    bout = __shfl(4 * lane + bb, Ls); nabout = __shfl(above, Ls);
}
__device__ __forceinline__ unsigned f16key(float v) { const _Float16 h = (_Float16)v; const unsigned short b = __builtin_bit_cast(unsigned short, h); return (b & 0x8000u) ? (unsigned)(~b & 0xffffu) : (unsigned)(b | 0x8000u); }
#define PINV(x) asm volatile("" : "+v"(x))
__device__ __forceinline__ void idx_scores(const bf16x8 (&kf)[4], const LAS unsigned char* QF, const float (&wq)[8], int lane, f32x16& sc) {
#pragma unroll
    for (int i = 0; i < 16; ++i) sc[i] = 0.f;
    bf16x8 qfr[2][4];
#pragma unroll
    for (int s = 0; s < 4; ++s) qfr[0][s] = *(const LAS bf16x8*)(QF + ((0 * 4 + s) * 64 + lane) * 16);
    f32x16 dprev;
#pragma unroll
    for (int hh = 0; hh < 9; ++hh) { f32x16 d;
        if (hh < 8) {
#pragma unroll
            for (int s = 0; s < 4; ++s) qfr[(hh + 1) & 1][s] = *(const LAS bf16x8*)(QF + (((hh + 1) * 4 + s) * 64 + lane) * 16);
        }
#pragma unroll
        for (int i = 0; i < 16; ++i) d[i] = 0.f;
#pragma unroll
        for (int s = 0; s < 4; ++s) { d = __builtin_amdgcn_mfma_f32_32x32x16_bf16(kf[s], qfr[hh & 1][s], d, 0, 0, 0); PINV(d);
            if (hh > 0) {
#pragma unroll
                for (int i = 4 * s; i < 4 * s + 4; ++i) { sc[i] = __builtin_fmaf(__builtin_fabsf(dprev[i]), wq[hh - 1], sc[i]); PINV(sc[i]); }
            } }
        dprev = d; }
#pragma unroll
    for (int i = 0; i < 16; ++i) sc[i] += dprev[i];
}
__device__ __forceinline__ void indexer_phase(Frame& F) {
    LAS unsigned char* QF = F.lds;
    LAS unsigned* H1 = (LAS unsigned*)(F.lds + 36864);
    LAS unsigned* H2 = (LAS unsigned*)(F.lds + 36864 + 33280);
    LAS int* QI = (LAS int*)(F.lds + 36864 + 2 * 33280);
    const bf16* QKV = (const bf16*)(F.ws + WS_QKV);
    unsigned short* SCR = (unsigned short*)(F.ws + WS_SCR) + (size_t)F.bid * (256 * 1024);
    const int lane = F.lane, n = lane & 31, hi = lane >> 5;
    for (int ui = 0; ui < 4; ++ui) {
        const int c = F.bid; const int uu = ui == 0 ? c : (ui == 1 ? 511 - c : (ui == 2 ? 512 + c : 1023 - c));
        if (F.G != 256) break;
        const int b = uu >> 8, qb = uu & 255, T0 = qb * 32; const size_t base = (size_t)b * SEQ;
        __syncthreads();
        for (int u = F.tid; u < 2 * 32 * 260; u += 512) H1[u] = 0u;
        for (int cc = F.tid; cc < 9 * 256; cc += 512) { const int hh = cc >> 8, s = (cc >> 6) & 3, ln = cc & 63, nn = ln & 31, h2 = ln >> 5;
            const bf16* qrow = QKV + (base + T0 + nn) * OD_INP;
            v4u o;
            if (hh < 8) o = *(const v4u*)(qrow + 1152 + hh * 64 + 16 * s + 8 * h2);
            else { float a[8];
#pragma unroll
                for (int e = 0; e < 8; ++e) a[e] = 0.f;
#pragma unroll
                for (int g = 0; g < 8; ++g) { const float w = 0.5f * WIS * bf2f(qrow[1728 + g]); const v4u q = *(const v4u*)(qrow + 1152 + g * 64 + 16 * s + 8 * h2);
                    a[0] += w * bflo(q.x); a[1] += w * bfhi(q.x); a[2] += w * bflo(q.y); a[3] += w * bfhi(q.y); a[4] += w * bflo(q.z); a[5] += w * bfhi(q.z); a[6] += w * bflo(q.w); a[7] += w * bfhi(q.w); }
                o.x = pk2(a[0], a[1]); o.y = pk2(a[2], a[3]); o.z = pk2(a[4], a[5]); o.w = pk2(a[6], a[7]); }
            *(LAS v4u*)(QF + cc * 16) = o; }
        float wq[8];
        { const bf16* qrow = QKV + (base + T0 + n) * OD_INP + 1728;
#pragma unroll
          for (int g = 0; g < 8; ++g) wq[g] = 0.5f * WIS * bf2f(qrow[g]); }
        __syncthreads();
        { bf16x8 kf[4], kn[4];
          const bf16* krow0 = QKV + (base + n) * OD_INP + 1664 + 8 * hi;
          if (F.wave <= qb) {
#pragma unroll
              for (int s = 0; s < 4; ++s) kf[s] = *(const bf16x8*)(krow0 + (size_t)(32 * F.wave) * OD_INP + 16 * s); }
          for (int j = F.wave; j <= qb; j += 8) {
            const bool more = j + 8 <= qb;
            if (more) {
#pragma unroll
                for (int s = 0; s < 4; ++s) kn[s] = *(const bf16x8*)(krow0 + (size_t)(32 * (j + 8)) * OD_INP + 16 * s); }
            f32x16 sc; idx_scores(kf, QF, wq, lane, sc);
            unsigned k16[16];
#pragma unroll
            for (int i = 0; i < 16; ++i) { const int key = 32 * j + crow(i, hi); const bool ok = key <= T0 + n; k16[i] = ok ? f16key(sc[i]) : 0u;
                if (ok) __hip_atomic_fetch_add(H1 + n * 260 + (k16[i] >> 8), 1u, __ATOMIC_RELAXED, __HIP_MEMORY_SCOPE_WORKGROUP); }
            unsigned short* sp = SCR + (size_t)j * 1024 + n * 32 + 4 * hi;
#pragma unroll
            for (int g = 0; g < 4; ++g) { v2u w; w.x = k16[4 * g] | (k16[4 * g + 1] << 16); w.y = k16[4 * g + 2] | (k16[4 * g + 3] << 16); *(v2u*)(sp + 8 * g) = w; }
            if (more) {
#pragma unroll
                for (int s = 0; s < 4; ++s) kf[s] = kn[s]; }
          } }
        VM_WAIT();
        __syncthreads();
        __builtin_amdgcn_fence(__ATOMIC_ACQUIRE, "agent");
        VM_WAIT();
        for (int qq = 0; qq < 4; ++qq) { const int nq = F.wave * 4 + qq, tpos = T0 + nq, K = tpos + 1 < 256 ? tpos + 1 : 256;
            int b1, nab; find_bin(H1 + nq * 260, K, lane, b1, nab);
            if (lane == 0) { QI[nq] = b1; QI[32 + nq] = nab; } }
        __syncthreads();
        const int qn = lane >> 1, hf = lane & 1;
        { const int b1 = QI[qn];
          for (int j0 = F.wave; j0 <= qb; j0 += 32) { v4u w[4][2];
#pragma unroll
            for (int u = 0; u < 4; ++u) { const int j = j0 + 8 * u; const v4u* rp = (const v4u*)(SCR + (size_t)(j <= qb ? j : j0) * 1024 + qn * 32 + hf * 16); w[u][0] = rp[0]; w[u][1] = rp[1]; }
#pragma unroll
            for (int u = 0; u < 4; ++u) { if (j0 + 8 * u <= qb) {
#pragma unroll
                for (int q4 = 0; q4 < 2; ++q4)
#pragma unroll
                    for (int e = 0; e < 4; ++e) { const unsigned lo = w[u][q4][e] & 0xffffu, hh = w[u][q4][e] >> 16;
                        if ((int)(lo >> 8) == b1) __hip_atomic_fetch_add(H2 + qn * 260 + (lo & 255u), 1u, __ATOMIC_RELAXED, __HIP_MEMORY_SCOPE_WORKGROUP);
                        if ((int)(hh >> 8) == b1) __hip_atomic_fetch_add(H2 + qn * 260 + (hh & 255u), 1u, __ATOMIC_RELAXED, __HIP_MEMORY_SCOPE_WORKGROUP); } } } } }
        __syncthreads();
        for (int qq = 0; qq < 4; ++qq) { const int nq = F.wave * 4 + qq, tpos = T0 + nq, K = tpos + 1 < 256 ? tpos + 1 : 256;
            const int b1 = QI[nq], nab = QI[32 + nq];
            int b2, nab2; find_bin(H2 + nq * 260, K - nab, lane, b2, nab2);
            if (lane == 0) { QI[64 + nq] = (b1 << 8) | b2; QI[96 + nq] = K - nab - nab2; }
            unsigned short* ip = (unsigned short*)(F.ws + WS_IDX) + (base + tpos) * 256;
            if (K < 256) { for (int p = K + lane; p < 256; p += 64) ip[p] = 0; } }
        __syncthreads();
        { const unsigned thr = (unsigned)QI[64 + qn];
          LAS unsigned char* CNT = (LAS unsigned char*)H1;
          for (int j0 = F.wave; j0 <= qb; j0 += 32) { v4u w[4][2];
#pragma unroll
            for (int u = 0; u < 4; ++u) { const int j = j0 + 8 * u; const v4u* rp = (const v4u*)(SCR + (size_t)(j <= qb ? j : j0) * 1024 + qn * 32 + hf * 16); w[u][0] = rp[0]; w[u][1] = rp[1]; }
#pragma unroll
            for (int u = 0; u < 4; ++u) { const int j = j0 + 8 * u; if (j <= qb) { int cgt = 0, ceq = 0;
#pragma unroll
                for (int q4 = 0; q4 < 2; ++q4)
#pragma unroll
                    for (int e = 0; e < 4; ++e) { const unsigned lo = w[u][q4][e] & 0xffffu, hh = w[u][q4][e] >> 16; cgt += (lo > thr) + (hh > thr); ceq += (lo == thr) + (hh == thr); }
                *(LAS unsigned short*)(CNT + (qn * 256 + j) * 4 + hf * 2) = (unsigned short)(cgt | (ceq << 8)); } } } }
        __syncthreads();
        for (int qq = 0; qq < 4; ++qq) { const int nq = F.wave * 4 + qq;
            const v4u cw = *(const LAS v4u*)(H1 + nq * 256 + 4 * lane);
            int g[4], e[4], sg = 0, se = 0;
#pragma unroll
            for (int k = 0; k < 4; ++k) { const unsigned w = (4 * lane + k <= qb) ? cw[k] : 0u; g[k] = (int)((w & 0xffu) + ((w >> 16) & 0xffu)); e[k] = (int)(((w >> 8) & 0xffu) + (w >> 24)); sg += g[k]; se += e[k]; }
            int pg = sg, pe = se;
#pragma unroll
            for (int off = 1; off < 64; off <<= 1) { const int vg = __shfl_up(pg, off), ve = __shfl_up(pe, off); if (lane >= off) { pg += vg; pe += ve; } }
            pg -= sg; pe -= se;
            v4u o;
#pragma unroll
            for (int k = 0; k < 4; ++k) { o[k] = (unsigned)pg | ((unsigned)pe << 16); pg += g[k]; pe += e[k]; }
            *(LAS v4u*)(H2 + nq * 256 + 4 * lane) = o; }
        __syncthreads();
        { const unsigned thr = (unsigned)QI[64 + qn]; const int mt = QI[96 + qn];
          const LAS unsigned char* CNT = (const LAS unsigned char*)H1;
          unsigned short* ip = (unsigned short*)(F.ws + WS_IDX) + (base + T0 + qn) * 256;
          for (int j0 = F.wave; j0 <= qb; j0 += 32) { v4u w[4][2];
#pragma unroll
            for (int u = 0; u < 4; ++u) { const int j = j0 + 8 * u;
                const bool need = j <= qb && *(const LAS unsigned short*)(CNT + (qn * 256 + j) * 4 + hf * 2) != 0;
                const v4u* rp = (const v4u*)(SCR + (need ? (size_t)j * 1024 + qn * 32 + hf * 16 : (size_t)0)); w[u][0] = rp[0]; w[u][1] = rp[1]; }
#pragma unroll
            for (int u = 0; u < 4; ++u) { const int j = j0 + 8 * u; if (j <= qb) {
            const unsigned of = H2[qn * 256 + j]; const unsigned c0 = *(const LAS unsigned short*)(CNT + (qn * 256 + j) * 4), cme = *(const LAS unsigned short*)(CNT + (qn * 256 + j) * 4 + hf * 2);
            int ng = (int)(of & 0xffffu) + (hf ? (int)(c0 & 0xffu) : 0), ne = (int)(of >> 16) + (hf ? (int)(c0 >> 8) : 0);
            if (cme) {
#pragma unroll
            for (int q4 = 0; q4 < 2; ++q4)
#pragma unroll
                for (int e = 0; e < 4; ++e)
#pragma unroll
                    for (int h2 = 0; h2 < 2; ++h2) { const unsigned kv = h2 ? (w[u][q4][e] >> 16) : (w[u][q4][e] & 0xffffu); const int key = j * 32 + hf * 16 + q4 * 8 + e * 2 + h2;
                        if (kv > thr) { ip[ng + (ne < mt ? ne : mt)] = (unsigned short)key; ++ng; }
                        else if (kv == thr) { if (ne < mt) ip[ng + ne] = (unsigned short)key; ++ne; } } } } } } }
    }
}
__device__ __forceinline__ void sparse_phase(Frame& F) {
    LAS unsigned char* btb = F.lds;
    LAS float* rtab = (LAS float*)(F.lds + 8192);
    LAS unsigned* tabs = (LAS unsigned*)(F.lds + 8192 + 2304 + F.wave * 4096);
    LAS unsigned char* vbuf = F.lds + 8192 + 2304 + 8 * 4096 + F.wave * 8192;
    __syncthreads();
    for (int u = F.tid; u < 8192; u += 512) btb[u] = (unsigned char)t5_bucket(u);
    { const int u = F.tid; rtab[u] = inp<I_REL>()[u] * LOG2E; if (u < 16) rtab[512 + u] = NEGF; }
    __syncthreads();
    const bf16* QKV = (const bf16*)(F.ws + WS_QKV);
    const int lane = F.lane, n = lane & 15, kb = lane >> 4;
    const int gw = F.bid * NWAVES + F.wave, NGW = F.G * NWAVES;
    const int q4 = (lane & 15) >> 2, p4 = lane & 3;
    int cur = 0;
    bf16x8 qf[2], kf[4][2], kn[4][2]; v4u vv[8], vn[8];
#define SP_TABS(BUF, IDX4, TPOS, NV) do { const v2u i4_ = (IDX4); v4u ro_, bo_; \
        _Pragma("unroll") for (int e_ = 0; e_ < 4; ++e_) { const unsigned iw_ = (e_ < 2) ? i4_.x : i4_.y; const int ki_ = (e_ & 1) ? (int)(iw_ >> 16) : (int)(iw_ & 0xffffu); \
            int dist_ = (TPOS) - ki_; dist_ = dist_ < 0 ? 0 : dist_; ro_[e_] = (unsigned)ki_ * (unsigned)(OD_INP * 2); bo_[e_] = (4 * lane + e_ < (NV)) ? (unsigned)btb[dist_] * 64u : 2048u; } \
        *(LAS v4u*)(tabs + (BUF) * 512 + 4 * lane) = ro_; *(LAS v4u*)(tabs + (BUF) * 512 + 256 + 4 * lane) = bo_; } while (0)
#define SP_GATHER(KD, VD, BUF, BASE, CK) do { const char* qb_ = (const char*)(QKV + (BASE) * OD_INP); \
        _Pragma("unroll") for (int jt = 0; jt < 4; ++jt) { const unsigned ro_ = tabs[(BUF) * 512 + 64 * (CK) + 16 * jt + n]; \
            const bf16* krow = (const bf16*)(qb_ + ro_) + 1024 + 8 * kb; KD[jt][0] = *(const bf16x8*)(krow); KD[jt][1] = *(const bf16x8*)(krow + 32); } \
        _Pragma("unroll") for (int i = 0; i < 8; ++i) { const int c = lane + 64 * i, key = c >> 3, ch = c & 7; const unsigned ro_ = tabs[(BUF) * 512 + 64 * (CK) + key]; \
            VD[i] = *(const v4u*)((const bf16*)(qb_ + ro_) + 1088 + ch * 8); } } while (0)
    if (gw < T) { const int tp0 = gw & 8191, nv0 = tp0 + 1 < 256 ? tp0 + 1 : 256;
        SP_TABS(0, *(const v2u*)((const unsigned short*)(F.ws + WS_IDX) + (size_t)gw * 256 + 4 * lane), tp0, nv0);
        { const bf16* qrow = QKV + (size_t)gw * OD_INP + n * 64 + 8 * kb; qf[0] = *(const bf16x8*)(qrow); qf[1] = *(const bf16x8*)(qrow + 32); }
        LDS_WAIT(); CBAR();
        SP_GATHER(kf, vv, 0, (size_t)(gw >> 13) * SEQ, 0);
    }
    for (int t = gw; t < T; t += NGW) {
        const int tpos = t & 8191, nv = tpos + 1 < 256 ? tpos + 1 : 256;
        const int tn = t + NGW; const bool hasn = tn < T;
        v2u inext = (v2u){0u, 0u}; bf16x8 qn0 = qf[0], qn1 = qf[1];
        if (hasn) { inext = *(const v2u*)((const unsigned short*)(F.ws + WS_IDX) + (size_t)tn * 256 + 4 * lane);
            const bf16* qrow = QKV + (size_t)tn * OD_INP + n * 64 + 8 * kb; qn0 = *(const bf16x8*)(qrow); qn1 = *(const bf16x8*)(qrow + 32); }
        float m = NEGF, l = 0.f;
        f32x4 o[4];
#pragma unroll
        for (int dt = 0; dt < 4; ++dt) o[dt] = (f32x4){0.f, 0.f, 0.f, 0.f};
        const int nck = (nv + 63) >> 6;
        for (int ck = 0; ck < nck; ++ck) {
            bool pre = false;
            if (ck + 1 < nck) { SP_GATHER(kn, vn, cur, (size_t)(t >> 13) * SEQ, ck + 1); pre = true; }
            else if (hasn) { const int tpn = tn & 8191, nvn = tpn + 1 < 256 ? tpn + 1 : 256; CBAR(); SP_TABS(cur ^ 1, inext, tpn, nvn); LDS_WAIT(); CBAR(); SP_GATHER(kn, vn, cur ^ 1, (size_t)(tn >> 13) * SEQ, 0); pre = true; }
            f32x4 sc[4]; float mx = NEGF;
#pragma unroll
            for (int jt = 0; jt < 4; ++jt) {
                f32x4 d = (f32x4){0.f, 0.f, 0.f, 0.f};
                d = __builtin_amdgcn_mfma_f32_16x16x32_bf16(kf[jt][0], qf[0], d, 0, 0, 0);
                d = __builtin_amdgcn_mfma_f32_16x16x32_bf16(kf[jt][1], qf[1], d, 0, 0, 0);
                const v4u bo = *(const LAS v4u*)(tabs + cur * 512 + 256 + 64 * ck + 16 * jt + 4 * kb);
#pragma unroll
                for (int i = 0; i < 4; ++i) { d[i] = d[i] * C2 + *(const LAS float*)((const LAS unsigned char*)rtab + bo[i] + 4 * n); mx = fmaxf(mx, d[i]); }
                sc[jt] = d; }
            mx = max16(mx); mx = max32(mx);
            const float mnew = fmaxf(m, mx), alpha = __builtin_amdgcn_exp2f(m - mnew);
            float rs = 0.f;
#pragma unroll
            for (int jt = 0; jt < 4; ++jt)
#pragma unroll
                for (int i = 0; i < 4; ++i) { sc[jt][i] = __builtin_amdgcn_exp2f(sc[jt][i] - mnew); rs += sc[jt][i]; }
            rs = sum16(rs); rs = sum32(rs);
            l = l * alpha + rs; m = mnew;
#pragma unroll
            for (int dt = 0; dt < 4; ++dt) o[dt] = o[dt] * alpha;
            CBAR();
#pragma unroll
            for (int i = 0; i < 8; ++i) { const int c = lane + 64 * i, key = c >> 3, ch = c & 7;
                *(LAS v4u*)(vbuf + (ch >> 1) * 2048 + key * 32 + (ch & 1) * 16) = vv[i]; }
            CBAR();
#pragma unroll
            for (int s2 = 0; s2 < 2; ++s2) {
                v4u pw; pw.x = pg8::cvt_pk_bf16(sc[2 * s2][0], sc[2 * s2][1]); pw.y = pg8::cvt_pk_bf16(sc[2 * s2][2], sc[2 * s2][3]); pw.z = pg8::cvt_pk_bf16(sc[2 * s2 + 1][0], sc[2 * s2 + 1][1]); pw.w = pg8::cvt_pk_bf16(sc[2 * s2 + 1][2], sc[2 * s2 + 1][3]);
                const bf16x8 pb = __builtin_bit_cast(bf16x8, pw);
                const LAS unsigned char* vb = vbuf + (32 * s2 + 4 * kb + q4) * 32 + 8 * p4;
#pragma unroll
                for (int dt = 0; dt < 4; ++dt) { const s16x4 lo = vtr(vb + dt * 2048), hh = vtr(vb + dt * 2048 + 16 * 32);
                    const bf16x8 va = (bf16x8){lo[0], lo[1], lo[2], lo[3], hh[0], hh[1], hh[2], hh[3]};
                    o[dt] = __builtin_amdgcn_mfma_f32_16x16x32_bf16(va, pb, o[dt], 0, 0, 0); } }
            CBAR();
            if (pre) {
#pragma unroll
                for (int jt = 0; jt < 4; ++jt) { kf[jt][0] = kn[jt][0]; kf[jt][1] = kn[jt][1]; }
#pragma unroll
                for (int i = 0; i < 8; ++i) vv[i] = vn[i]; }
        }
        const float inv = 1.f / l;
        if (PROJ_FP8) { unsigned char* o8p = (unsigned char*)(F.ws + WS_O) + (size_t)t * D + n * 64 + 4 * kb;
#pragma unroll
            for (int dt = 0; dt < 4; ++dt) *(unsigned*)(o8p + 16 * dt) = pk4_fp8(o[dt][0] * inv, o[dt][1] * inv, o[dt][2] * inv, o[dt][3] * inv); }
        else {
        bf16* op = (bf16*)(F.ws + WS_O) + (size_t)t * D + n * 64 + 4 * kb;
#pragma unroll
        for (int dt = 0; dt < 4; ++dt) { v2u w; w.x = pg8::cvt_pk_bf16(o[dt][0] * inv, o[dt][1] * inv); w.y = pg8::cvt_pk_bf16(o[dt][2] * inv, o[dt][3] * inv); *(v2u*)(op + 16 * dt) = w; } }
        cur ^= 1; qf[0] = qn0; qf[1] = qn1;
    }
#undef SP_GATHER
#undef SP_TABS
}

constexpr int N_PHASES = 2 + 9 * DEPTH;
struct Args { const float* in[19]; float* out; unsigned char* ws; int ph_lo, ph_hi; };
__global__ void __launch_bounds__(NWAVES * 64, 2) mk_fwd(Args args) {
    extern __shared__ __attribute__((aligned(16))) unsigned char lds[];
    Frame F;
    F.lds = (LAS unsigned char*)lds;
    F.tid = threadIdx.x; F.lane = F.tid & 63; F.wave = __builtin_amdgcn_readfirstlane(F.tid >> 6);
    F.G = gridDim.x; F.bid = blockIdx.x;
    F.XR = args.out; F.ws = args.ws;
    volatile LAS unsigned* MISC = (volatile LAS unsigned*)(F.lds + MISC_OFF);
    for (int u = F.tid; u < (LDS_BYTES - RING_BYTES) / 4; u += NWAVES * 64) ((LAS unsigned*)(F.lds + RING_BYTES))[u] = 0u;
    __syncthreads();
    (void)xcd_barrier_post((unsigned*)(F.ws + WS_CTL) + 1024, MISC + 8);
#if MK_SPLIT
    const int lo = args.ph_lo, hi = args.ph_hi;
#else
    constexpr int lo = 0, hi = N_PHASES;
#endif
#define IN(k) (lo <= (k) && (k) < hi)
#define LAUNDER() do { asm volatile("" : "+v"(F.tid)); F.lane = F.tid & 63; F.wave = __builtin_amdgcn_readfirstlane(F.tid >> 6); asm volatile("" : "+s"(F.ws), "+s"(F.bid), "+s"(F.G)); } while (0)
#define SEAM(k) do { if (IN((k) + 1)) { XcdBarrier b_; b_.bar = (unsigned*)(F.ws + WS_CTL) + 1024; b_.x = xb_xcc_id(); b_.st = (volatile LAS unsigned*)(F.lds + MISC_OFF) + 8; xcd_barrier(b_); } } while (0)

    if (IN(0)) { LAUNDER(); REP(0) { conv_small(F); conv_ffn(F, 0); mod_phase(F); } SEAM(0); }
    if (IN(1)) { LAUNDER(); REP(1) h0_phase(F); SEAM(1); }

#pragma nounroll
    for (int layer = 0; layer < DEPTH; ++layer) {
        const int pb = 2 + 9 * layer, li = layer >> 1; const bool odd = layer & 1;
        if (IN(pb + 0)) { LAUNDER();
            const int N = odd ? OD_INP : EV_IN;
            const bool f8 = !odd && PROJ_FP8;
            pg8::Gemm g{(const bf16*)(F.ws + WS_H), f8 ? (const bf16*)((const unsigned char*)(F.ws + WS_WINE) + (size_t)li * N * D) : (const bf16*)(F.ws + (odd ? WS_WINO : WS_WINE)) + (size_t)li * N * D, T, N, f8 ? D / 2 : D};
            REP(odd ? 11 : 2) {
            dense_units(F);
            pg8::GroupOrder S; S.init(T / 256, N / 256, F.G, F.bid, US);
            pg8::EpiOut E{1, (void*)(F.ws + WS_QKV), N, N / 256, nullptr, 0, nullptr, f8 ? (1.f / 32.f) : 1.f};
            if (f8) pg8::gemm_phase<pg8::EpiOut, pg8::GroupOrder, true, true, true>(F.lds, g, S, E, F.tid);
            else pg8::gemm_phase<pg8::EpiOut, pg8::GroupOrder, true, true, false>(F.lds, g, S, E, F.tid); }
            SEAM(pb + 0);
        }
        if (IN(pb + 1)) { LAUNDER();
#ifndef SKIP_BAND
            if (!odd) REP(3) band_phase(F, li);
#endif
#ifndef SKIP_IDX
            if (odd) REP(12) indexer_phase(F);
#endif
            SEAM(pb + 1); }
        if (IN(pb + 2)) { LAUNDER();
#ifndef SKIP_SPARSE
            if (odd) { REP(13) sparse_phase(F); SEAM(pb + 2); }
#endif
        }
        if (IN(pb + 3)) { LAUNDER();
            __syncthreads();
            pg8::Gemm g{(const bf16*)(F.ws + WS_O), PROJ_FP8 ? (const bf16*)((const unsigned char*)(F.ws + (odd ? WS_WOO : WS_WOE)) + (size_t)li * D * D) : (const bf16*)(F.ws + (odd ? WS_WOO : WS_WOE)) + (size_t)li * D * D, T, D, PROJ_FP8 ? D / 2 : D};
            dense_units(F);
            pg8::GroupOrder S; S.init(T / 256, D / 256, F.G, F.bid, US);
            pg8::EpiOut E{0, (void*)(F.ws + WS_XH), 0, D / 256, layer == 0 ? (const void*)inp<I_X>() : (const void*)(F.ws + WS_XH), layer == 0 ? 1 : 0, mod_ptr(F, layer * 2, 2, 0), PROJ_FP8 ? (1.f / 64.f) : 1.f};
            pg8::gemm_phase<pg8::EpiOut, pg8::GroupOrder, true, true, (PROJ_FP8 != 0)>(F.lds, g, S, E, F.tid);
            SEAM(pb + 3);
        }
        if (IN(pb + 4)) { LAUNDER(); if (!odd) ln_phase<0>(F, layer, 0, false); else ln_phase<1>(F, layer, 0, false); SEAM(pb + 4); }
        if (IN(pb + 5)) { LAUNDER(); if (odd) { REP(16) gather_phase(F, layer); SEAM(pb + 5); } }
        if (IN(pb + 6)) { LAUNDER();
            REP(odd ? 17 : 8) {
            if (odd) moe_units(F); else dense_units(F);
            pg8::GroupOrder S; S.init(US[8], 2 * FF / 256, F.G, F.bid, US);
            const bool f8 = odd ? UP_FP8_MOE : UP_FP8_DENSE;
            pg8::Gemm g{(const bf16*)(F.ws + (odd ? WS_XB : WS_H)), (const bf16*)(F.ws + WS_W13), T, 2 * FF, f8 ? D / 2 : D};
            pg8::EpiSwiGLU E{(bf16*)(F.ws + (odd ? WS_UM : WS_U)), FF, 2 * FF / 256, nullptr, f8 ? (1.f / 32.f) : 1.f, (odd ? DOWN_FP8_MOE : DOWN_FP8_DENSE) ? 1 : 0};
            if (f8) pg8::gemm_phase<pg8::EpiSwiGLU, pg8::GroupOrder, true, true, true>(F.lds, g, S, E, F.tid);
            else pg8::gemm_phase<pg8::EpiSwiGLU, pg8::GroupOrder, true, true, false>(F.lds, g, S, E, F.tid); }
            SEAM(pb + 6);
        }
        if (IN(pb + 7)) { LAUNDER();
            if (odd) moe_units(F); else dense_units(F);
            pg8::GroupOrder S; S.init(US[8], D / 256, F.G, F.bid, US);
            const bool f8 = odd ? DOWN_FP8_MOE : DOWN_FP8_DENSE;
            pg8::Gemm g{(const bf16*)(F.ws + (odd ? WS_UM : WS_U)), (const bf16*)(F.ws + WS_W2), T, D, f8 ? FF / 2 : FF};
            pg8::EpiOut E{odd ? 1 : 0, odd ? (void*)(F.ws + WS_XB) : (void*)(F.ws + WS_XH), D, D / 256, (const void*)(F.ws + WS_XH), 0, mod_ptr(F, layer * 2 + 1, 2, 0), f8 ? (1.f / 128.f) : 1.f};
            if (f8) pg8::gemm_phase<pg8::EpiOut, pg8::GroupOrder, true, true, true>(F.lds, g, S, E, F.tid);
            else pg8::gemm_phase<pg8::EpiOut, pg8::GroupOrder, true, true, false>(F.lds, g, S, E, F.tid);
            SEAM(pb + 7);
        }
        if (IN(pb + 8)) { LAUNDER();
            __syncthreads();
            if (!odd) ln_phase<0>(F, layer, 1, layer == DEPTH - 1); else ln_phase<2>(F, layer, 1, layer == DEPTH - 1);
            if (layer + 1 < DEPTH) { __syncthreads(); conv_ffn(F, layer + 1); }
            SEAM(pb + 8);
        }
    }
#undef IN
#undef SEAM
}

extern "C" void kernel_launch(void* const* d_in, const int* in_sizes, int n_in, void* d_out, int out_size, void* d_ws, size_t ws_size, hipStream_t stream) {
    static int grid = 0;
    if (grid == 0) {
        if (n_in != 19 || out_size != T * D || ws_size < WS_END) { fprintf(stderr, "kernel_launch: unexpected shapes (n_in %d out %d ws %zu need %zu)\n", n_in, out_size, ws_size, (size_t)WS_END); grid = -1; return; }
        int dev = 0, cus = 0;
        if (hipGetDevice(&dev) != hipSuccess || hipDeviceGetAttribute(&cus, hipDeviceAttributeMultiprocessorCount, dev) != hipSuccess) { grid = -1; return; }
        if (hipFuncSetAttribute((const void*)mk_fwd, hipFuncAttributeMaxDynamicSharedMemorySize, LDS_BYTES) != hipSuccess) { grid = -1; return; }
        int per_cu = 0;
        (void)hipOccupancyMaxActiveBlocksPerMultiprocessor(&per_cu, (const void*)mk_fwd, NWAVES * 64, LDS_BYTES);
        (void)hipGetLastError();
        grid = cus;
        if (grid != 256) fprintf(stderr, "kernel_launch: built for 256 CUs, got %d\n", grid);
    }
    if (grid < 0) return;
    (void)hipMemsetAsync((char*)d_ws + WS_CTL, 0, CTL_ZERO_BYTES, stream);
    Args a{};
    for (int i = 0; i < 19; ++i) a.in[i] = (const float*)d_in[i];
    a.out = (float*)d_out; a.ws = (unsigned char*)d_ws;
#if MK_SPLIT
    for (int p = 0; p < N_PHASES; ++p) { a.ph_lo = p; a.ph_hi = p + 1; hipLaunchKernelGGL(mk_fwd, dim3(grid), dim3(NWAVES * 64), LDS_BYTES, stream, a); }
#else
    a.ph_lo = 0; a.ph_hi = N_PHASES;
    hipLaunchKernelGGL(mk_fwd, dim3(grid), dim3(NWAVES * 64), LDS_BYTES, stream, a);
#endif
}

#ifdef PHASE_TEST
#define MK_TEST_KERNEL(name, body) __global__ void __launch_bounds__(512, 2) name(Args args) { extern __shared__ __attribute__((aligned(16))) unsigned char lds[]; Frame F; F.lds = (LAS unsigned char*)lds; \
    F.tid = threadIdx.x; F.lane = F.tid & 63; F.wave = __builtin_amdgcn_readfirstlane(F.tid >> 6); F.G = gridDim.x; F.bid = blockIdx.x; F.XR = args.out; F.ws = args.ws; body; }
MK_TEST_KERNEL(t_band, band_phase(F, 0))
MK_TEST_KERNEL(t_idx, indexer_phase(F))
MK_TEST_KERNEL(t_sparse, sparse_phase(F))
MK_TEST_KERNEL(t_ln0, ln_phase<0>(F, 0, 0, false))
MK_TEST_KERNEL(t_ln1, ln_phase<1>(F, 1, 0, false))
MK_TEST_KERNEL(t_ln2, ln_phase<2>(F, 1, 1, false))
MK_TEST_KERNEL(t_gather, gather_phase(F, 1))
MK_TEST_KERNEL(t_p0, conv_small(F); conv_ffn(F, 0); mod_phase(F))
#endif
```
